# Optimizing an MI355X kernel written in HIP

```python
import math
import jax, jax.numpy as jnp
from jax import lax
import numpy as np

D_MODEL = 4096
BATCH = 2
SEQ = 8192
DEPTH = 1

GRID_W = 64
CTX_LEN = 256

NA_HEAD_DIM = 128
NA_WIDTH = D_MODEL // 2
NA_HEADS = NA_WIDTH // NA_HEAD_DIM
NA_KH = 8
NA_KW = 16

HG_HEADS = 16
HG_KDIM = 128
HG_VDIM = (D_MODEL // 2) // HG_HEADS
HG_WIDTH = HG_HEADS * HG_KDIM
HG_CHUNK = 64

ALPHA = (2.0 * DEPTH) ** 0.25
BETA = (8.0 * DEPTH) ** -0.25
LN_EPS = 1e-6
RMS_EPS = 1e-6

kernel_name = 'hybrid_na_hgrn2_dit_block'


def _in_sizes():
    return [NA_WIDTH] * 4 + [HG_WIDTH] * 5 + [D_MODEL] * 2


def _split_points():
    return [int(p) for p in np.cumsum(_in_sizes())[:-1]]


def layer_norm(x):
    x32 = x.astype(jnp.float32)
    mu = jnp.mean(x32, axis=-1, keepdims=True)
    var = jnp.mean(jnp.square(x32 - mu), axis=-1, keepdims=True)
    return ((x32 - mu) * lax.rsqrt(var + LN_EPS)).astype(x.dtype)


def adaln_params(cond, w_ada, b_ada):
    mod = jax.nn.silu(cond) @ w_ada + b_ada
    return jnp.split(mod, 3, axis=-1)


def split_heads(t, n_heads):
    b, n, w = t.shape
    return t.reshape(b, n, n_heads, w // n_heads).transpose(0, 2, 1, 3)


def merge_heads(t):
    b, h, n, d = t.shape
    return t.transpose(0, 2, 1, 3).reshape(b, n, h * d)


def neighbourhood_attention(q, k, v, k_ctx, v_ctx, rpb):
    b, h, t, dh = q.shape
    rows = t // GRID_W
    kh = min(NA_KH, rows)
    qg = q.reshape(b, h, rows, GRID_W, dh) * (dh ** -0.5)
    kg = k.reshape(b, h, rows, GRID_W, dh)
    vg = v.reshape(b, h, rows, GRID_W, dh)
    r = jnp.arange(rows)
    row_start = jnp.clip(r - NA_KH // 2, 0, rows - kh)
    row_idx = row_start[:, None] + jnp.arange(kh)[None, :]
    k_strip = kg[:, :, row_idx].reshape(b, h, rows, kh * GRID_W, dh)
    v_strip = vg[:, :, row_idx].reshape(b, h, rows, kh * GRID_W, dh)
    col = jnp.arange(GRID_W)
    col_start = jnp.clip(col - NA_KW // 2, 0, GRID_W - NA_KW)
    col_in = (col[None, :] >= col_start[:, None]) & (col[None, :] < col_start[:, None] + NA_KW)
    d_row = row_idx - r[:, None]
    d_col = jnp.clip(col[None, :] - col[:, None], -(NA_KW - 1), NA_KW - 1)
    bias = rpb.astype(jnp.float32)[:, d_row[:, None, :, None] + NA_KH - 1,
                                   d_col[None, :, None, :] + NA_KW - 1]
    bias = jnp.where(col_in[:, None, :], bias, -jnp.inf).reshape(h, rows, GRID_W, kh * GRID_W)
    s_loc = jnp.einsum('bhrqd,bhrkd->bhrqk', qg, k_strip).astype(jnp.float32) + bias[None]
    s_ctx = jnp.einsum('bhrqd,bhld->bhrql', qg, k_ctx).astype(jnp.float32)
    p = jax.nn.softmax(jnp.concatenate([s_loc, s_ctx], axis=-1), axis=-1).astype(v.dtype)
    n_loc = kh * GRID_W
    o = (jnp.einsum('bhrqk,bhrkd->bhrqd', p[..., :n_loc], v_strip)
         + jnp.einsum('bhrql,bhld->bhrqd', p[..., n_loc:], v_ctx))
    return o.reshape(b, h, t, dh)


def context_attention(q, k, v):
    s = jnp.einsum('bhqd,bhkd->bhqk', q, k).astype(jnp.float32) * (q.shape[-1] ** -0.5)
    p = jax.nn.softmax(s, axis=-1).astype(v.dtype)
    return jnp.einsum('bhqk,bhkd->bhqd', p, v)


def hgrn2_lower_bound(lb_logits, layer):
    lb = jnp.cumsum(jax.nn.softmax(lb_logits.astype(jnp.float32), axis=0), axis=0)[layer]
    return lb.reshape(HG_HEADS, 1, HG_KDIM)


def hgrn2_forget(f_pre, lb):
    f_pre = f_pre.astype(jnp.float32)
    f = lb + (1.0 - lb) * jax.nn.sigmoid(f_pre)
    return (1.0 - lb) * jax.nn.sigmoid(-f_pre), jnp.log(f)


def gla_chunked(q, k, v, log_f, s0):
    b, h, t, dk = q.shape
    dv = v.shape[-1]
    n, c = t // HG_CHUNK, HG_CHUNK
    qc = q.reshape(b, h, n, c, dk)
    kc = k.reshape(b, h, n, c, dk)
    vc = v.reshape(b, h, n, c, dv)
    cum = jnp.cumsum(log_f.reshape(b, h, n, c, dk), axis=3)
    ref = cum[:, :, :, c // 2 - 1:c // 2]
    a = jnp.einsum('bhncd,bhnsd->bhncs', qc * jnp.exp(cum - ref), kc * jnp.exp(ref - cum))
    a = jnp.where(jnp.tril(jnp.ones((c, c), dtype=bool)), a, 0.0)
    o_intra = jnp.einsum('bhncs,bhnsv->bhncv', a, vc)
    last = cum[:, :, :, -1]
    u = jnp.einsum('bhncd,bhncv->bhndv', kc * jnp.exp(last[:, :, :, None] - cum), vc)

    def step(s, inp):
        decay, du = inp
        return decay[..., None] * s + du, s

    s_last, s_start = lax.scan(step, s0, (jnp.moveaxis(jnp.exp(last), 2, 0), jnp.moveaxis(u, 2, 0)))
    s_start = jnp.moveaxis(s_start, 0, 2)
    o_inter = jnp.einsum('bhncd,bhndv->bhncv', qc * jnp.exp(cum), s_start)
    return (o_intra + o_inter).reshape(b, h, t, dv), s_last


def hgrn2_readout(o, g, norm_w):
    o = o * lax.rsqrt(jnp.mean(jnp.square(o), axis=-1, keepdims=True) + RMS_EPS) * norm_w
    return merge_heads(o.astype(g.dtype)) * jax.nn.silu(g)


def merge_branches(y_a, y_b, gate_a, gate_b, w_pa, w_pb, w_out):
    m = jax.nn.sigmoid(gate_a) * (y_a @ w_pa) + jax.nn.sigmoid(gate_b) * (y_b @ w_pb)
    return m @ w_out


def trunk_layer(x, ctx, c, c_ctx, w_ada, b_ada, w_in, na_rpb, lb_fwd, lb_bwd, hg_norm_w,
                w_pa, w_pb, w_out, ln_g, ln_b, layer, update_ctx):
    bsz = x.shape[0]
    L = ctx.shape[1]
    shift, scale, gate = adaln_params(c, w_ada, b_ada)
    shift_c, scale_c, gate_c = adaln_params(c_ctx, w_ada, b_ada)
    h_lat = layer_norm(x) * (1.0 + scale[:, None]) + shift[:, None]
    h_ctx = layer_norm(ctx) * (1.0 + scale_c) + shift_c
    proj = jnp.concatenate([h_ctx, h_lat], axis=1) @ w_in
    (na_q, na_k, na_v, na_z, hg_q, hg_ff, hg_fb, hg_i, hg_g,
     gate_a, gate_b) = jnp.split(proj, _split_points(), axis=-1)

    q, k, v = (split_heads(t, NA_HEADS) for t in (na_q, na_k, na_v))
    o_a = neighbourhood_attention(q[:, :, L:], k[:, :, L:], v[:, :, L:], k[:, :, :L], v[:, :, :L], na_rpb)
    y_a = merge_heads(o_a) * jax.nn.silu(na_z[:, L:])

    hq = split_heads(jax.nn.silu(hg_q), HG_HEADS).astype(jnp.float32)
    hv = split_heads(hg_i, HG_HEADS).astype(jnp.float32)
    k_f, logf_f = hgrn2_forget(split_heads(hg_ff, HG_HEADS), hgrn2_lower_bound(lb_fwd, layer))
    k_b, logf_b = hgrn2_forget(split_heads(hg_fb, HG_HEADS), hgrn2_lower_bound(lb_bwd, layer))
    rev = lambda t: jnp.flip(t, axis=2)
    s0 = jnp.zeros((bsz, HG_HEADS, HG_KDIM, HG_VDIM), jnp.float32)
    o_cf, s_cf = gla_chunked(hq[:, :, :L], k_f[:, :, :L], hv[:, :, :L], logf_f[:, :, :L], s0)
    o_cb, s_cb = gla_chunked(rev(hq[:, :, :L]), rev(k_b[:, :, :L]), rev(hv[:, :, :L]),
                             rev(logf_b[:, :, :L]), s0)
    o_lf, _ = gla_chunked(hq[:, :, L:], k_f[:, :, L:], hv[:, :, L:], logf_f[:, :, L:], s_cf)
    o_lb, _ = gla_chunked(rev(hq[:, :, L:]), rev(k_b[:, :, L:]), rev(hv[:, :, L:]),
                          rev(logf_b[:, :, L:]), s_cb)
    y_b = hgrn2_readout(o_lf + rev(o_lb), hg_g[:, L:], hg_norm_w)

    out = merge_branches(y_a, y_b, gate_a[:, L:], gate_b[:, L:], w_pa, w_pb, w_out)
    x_new = layer_norm(ALPHA * x + gate[:, None] * out) * ln_g + ln_b
    if not update_ctx:
        return x_new, ctx

    y_ac = merge_heads(context_attention(q[:, :, :L], k[:, :, :L], v[:, :, :L])) * jax.nn.silu(na_z[:, :L])
    y_bc = hgrn2_readout(o_cf + rev(o_cb), hg_g[:, :L], hg_norm_w)
    out_c = merge_branches(y_ac, y_bc, gate_a[:, :L], gate_b[:, :L], w_pa, w_pb, w_out)
    ctx_new = layer_norm(ALPHA * ctx + gate_c * out_c) * ln_g + ln_b
    return x_new, ctx_new


def setup_inputs(seed: int = 0) -> dict:
    key = jax.random.key(seed)
    ks = jax.random.split(key, 16)
    d = D_MODEL
    nrm = jax.random.normal
    sizes = _in_sizes()
    n_in = sum(sizes)
    col_scale = jnp.concatenate([jnp.full((s,), BETA if j in (2, 7) else 1.0, jnp.float32)
                                 for j, s in enumerate(sizes)])
    return {
        'x': nrm(ks[0], (BATCH, SEQ, d), jnp.float32),
        'c': nrm(ks[1], (BATCH, d), jnp.float32),
        'ctx': nrm(ks[2], (BATCH, CTX_LEN, d), jnp.float32),
        'c_ctx': nrm(ks[3], (d,), jnp.float32),
        'w_ada': nrm(ks[4], (DEPTH, d, 3 * d), jnp.float32) * (0.5 * d ** -0.5),
        'b_ada': nrm(ks[5], (DEPTH, 3 * d), jnp.float32) * 0.01,
        'w_in': nrm(ks[6], (DEPTH, d, n_in), jnp.float32) * (d ** -0.5) * col_scale,
        'na_rpb': nrm(ks[7], (DEPTH, NA_HEADS, 2 * NA_KH - 1, 2 * NA_KW - 1), jnp.float32) * 0.02,
        'hg_lb_fwd': nrm(ks[8], (DEPTH + 1, HG_WIDTH), jnp.float32) * 0.1,
        'hg_lb_bwd': nrm(ks[9], (DEPTH + 1, HG_WIDTH), jnp.float32) * 0.1,
        'hg_norm_w': 1.0 + 0.01 * nrm(ks[10], (DEPTH, HG_VDIM), jnp.float32),
        'w_pa': nrm(ks[11], (DEPTH, NA_WIDTH, d), jnp.float32) * (NA_WIDTH ** -0.5) * BETA,
        'w_pb': nrm(ks[12], (DEPTH, HG_WIDTH, d), jnp.float32) * (HG_WIDTH ** -0.5) * BETA,
        'w_out': nrm(ks[13], (DEPTH, d, d), jnp.float32) * (d ** -0.5) * BETA,
        'ln_g': 1.0 + 0.01 * nrm(ks[14], (DEPTH, d), jnp.float32),
        'ln_b': 0.01 * nrm(ks[15], (DEPTH, d), jnp.float32),
    }


def reference(x, c, ctx, c_ctx, w_ada, b_ada, w_in, na_rpb, hg_lb_fwd, hg_lb_bwd, hg_norm_w,
              w_pa, w_pb, w_out, ln_g, ln_b):
    for l in range(DEPTH):
        x, ctx = trunk_layer(x, ctx, c, c_ctx, w_ada[l], b_ada[l], w_in[l], na_rpb[l],
                             hg_lb_fwd, hg_lb_bwd, hg_norm_w[l], w_pa[l], w_pb[l], w_out[l],
                             ln_g[l], ln_b[l], l, l < DEPTH - 1)
    return x
```

```cpp
#include <hip/hip_runtime.h>
#include <hip/hip_cooperative_groups.h>
#include <cstdio>
namespace cg = cooperative_groups;

#define DI __device__ __forceinline__
#define LAS __attribute__((address_space(3)))
typedef unsigned short bf16_t;
typedef short bf16x8 __attribute__((ext_vector_type(8)));
typedef short s16x4 __attribute__((ext_vector_type(4)));
typedef float f32x4 __attribute__((ext_vector_type(4)));
typedef unsigned u32x4 __attribute__((ext_vector_type(4)));
typedef unsigned u32x2 __attribute__((ext_vector_type(2)));

constexpr int DM = 4096, NB = 2, TT = 8192, LC = 256;
constexpr int NLAT = NB * TT;
constexpr int MROWS = NLAT + NB * LC;
constexpr int NIN = 26624;
constexpr int C_Q = 0, C_K = 2048, C_V = 4096, C_Z = 6144, C_HQ = 8192, C_FF = 10240, C_FB = 12288, C_HI = 14336, C_HG = 16384, C_GA = 18432, C_GB = 22528;
constexpr float ALPHA_F = 1.189207115002721f;
constexpr int NTHREADS = 512;
constexpr int LDS_BYTES = 131072 + 8192 + 256;

constexpr size_t WS_WIN = 0;
constexpr size_t WS_H = WS_WIN + (size_t)NIN * DM * 2;
constexpr size_t WS_O = 0;
constexpr size_t WS_P = WS_H + (size_t)MROWS * DM * 2;
constexpr size_t WS_WPA = WS_P + (size_t)MROWS * NIN * 2;
constexpr size_t WS_WPB = WS_WPA + (size_t)DM * 2048 * 2;
constexpr size_t WS_WOUT = WS_WPB + (size_t)DM * 2048 * 2;
constexpr size_t WS_YA = WS_WOUT + (size_t)DM * DM * 2;
constexpr size_t WS_YB = WS_YA + (size_t)NLAT * 2048 * 2;
constexpr size_t WS_M = WS_YB + (size_t)NLAT * 2048 * 2;
constexpr size_t WS_MOD = WS_M + (size_t)NLAT * DM * 2;
constexpr size_t WS_BAR = WS_MOD + 3 * 12288 * 4;
constexpr size_t WS_CNT = WS_BAR + 3456 * 4;
constexpr size_t WS_SLOT = WS_CNT + 64 * 64 * 4;
constexpr size_t WS_END = WS_SLOT + (size_t)NLAT * 16 * 8;
constexpr size_t ZERO_BYTES = WS_SLOT - WS_BAR;
static_assert((size_t)2 * NLAT * 2048 * 4 <= WS_P, "O alias must fit before P");

struct Params {
    const float* x; const float* c; const float* ctx; const float* c_ctx; const float* w_ada; const float* b_ada; const float* w_in;
    const float* rpb; const float* lb_fwd; const float* lb_bwd; const float* hg_nw; const float* w_pa; const float* w_pb; const float* w_out;
    const float* ln_g; const float* ln_b;
    float* out; unsigned char* ws;
    int ph_lo, ph_hi;
};

DI size_t oix(int dir, int tok, int h, int v) { return (((size_t)(dir * 16 + h)) * NLAT + (size_t)tok) * 128 + (size_t)v; }
DI size_t pix(int row, int col) { return ((size_t)(col >> 8) * MROWS + (size_t)row) * 256 + (size_t)(col & 255); }
DI bf16_t f2bf(float f) { unsigned u = __float_as_uint(f); u += 0x7FFFu + ((u >> 16) & 1u); return (bf16_t)(u >> 16); }
DI float bf2f(unsigned b) { return __uint_as_float(b << 16); }
DI float bflo(unsigned w) { return __uint_as_float(w << 16); }
DI float bfhi(unsigned w) { return __uint_as_float(w & 0xffff0000u); }
DI unsigned cvt_pk_bf16(float lo, float hi) { unsigned r; asm volatile("v_cvt_pk_bf16_f32 %0, %1, %2" : "=v"(r) : "v"(lo), "v"(hi)); return r; }
DI float wave_sum(float v) { v += __shfl_xor(v, 32); v += __shfl_xor(v, 16); v += __shfl_xor(v, 8); v += __shfl_xor(v, 4); v += __shfl_xor(v, 2); v += __shfl_xor(v, 1); return v; }
DI float sigmoidf_(float v) { return __builtin_amdgcn_rcpf(1.0f + __expf(-v)); }
DI float siluf_(float v) { return v * __builtin_amdgcn_rcpf(1.0f + __expf(-v)); }
#define MFMA16(a, b, c) __builtin_amdgcn_mfma_f32_16x16x32_bf16((a), (b), (c), 0, 0, 0)

namespace pg8 {
constexpr int BM = 256, BK = 64, HALF = 128, HTB = HALF * BK * 2, STAGE_BYTES = 8 * HTB, NXCD = 8, WGM = 8;
DI int lds_byte(int r, int c) { const int st = (r >> 4) * 2 + (c >> 5), rr = r & 15, cc = c & 31, ob = rr * 64 + cc * 2; return st * 1024 + (ob ^ (((ob >> 9) & 1) << 5)); }
DI void stage_rc(int b, int& R, int& C) { const int st = b / 1024, sb = b % 1024, swz = sb ^ (((sb >> 9) & 1) << 5); R = (st >> 1) * 16 + swz / 64; C = (st & 1) * 32 + (swz % 64) / 2; }
DI int perm32(int rho) { const int n = rho >> 4, i = rho & 15; return 8 * (i >> 2) + 4 * n + (i & 3); }

struct Unit { int pm, pn, z; };
struct Gemm { const bf16_t* A; const bf16_t* Bt; const bf16_t* A2; const bf16_t* Bt2; int M, N, K, ld; };

template <int ZN> struct StaticOrder {
    int nM, nN, nwg, G, c;
    DI void init(int M, int N, int G_, int c_) { nM = M / BM; nN = N / BM; nwg = nM * nN; G = G_; c = c_; }
    DI bool next(int i, Unit& u) const {
        const int it = (ZN == 2) ? (i >> 1) : i;
        const long L = (long)it * G + c; if (L >= nwg) return false;
        int wgid = (int)L; { const int q = nwg / NXCD, r = nwg % NXCD, xcd = wgid % NXCD, off = wgid / NXCD; wgid = (xcd < r ? xcd * (q + 1) : r * (q + 1) + (xcd - r) * q) + off; }
        const int nig = WGM * nN, gid = wgid / nig, fm = gid * WGM, gsz = (nM - fm) < WGM ? (nM - fm) : WGM;
        u.pm = fm + ((wgid % nig) % gsz); u.pn = (wgid % nig) / gsz; u.z = (ZN == 2) ? (i & 1) : 0; return true;
    }
};

template <class Epi, class Sched>
DI void gemm_phase(LAS unsigned char* lds, const Gemm g, const Sched& S, const Epi& E) {
    const int tid = threadIdx.x, wid = __builtin_amdgcn_readfirstlane(tid >> 6), lane = tid & 63, wr = wid >> 2, wc = wid & 3, fr = lane & 15, fq = lane >> 4;
    const int K = g.K, nt = K / BK, LD = g.ld;
    unsigned voffA[2], voffB[2];
#pragma unroll
    for (int i = 0; i < 2; ++i) { int R, C; stage_rc(tid * 16 + i * 8192, R, C); const int Rb = Epi::PERM ? ((R & ~31) + perm32(R & 31)) : R;
        voffA[i] = (unsigned)(R * LD + C) * 2u; voffB[i] = (unsigned)(Rb * LD + C) * 2u; }
    const size_t kstep = (size_t)(BK * 2);
    const size_t hstep = (size_t)HALF * LD * 2;
    const size_t tstep = 2 * hstep;
    const unsigned ldsw = (unsigned)wid * 1024u;
    const int aoff = lds_byte(wr * 64 + fr, fq * 8), boff = lds_byte(wc * 32 + fr, fq * 8);
#define PG8_SA(b, h) (((b) * 2 + (h)) * HTB)
#define PG8_SB(b, h) ((4 + (b) * 2 + (h)) * HTB)
#define PG8_STAGE(bufoff, gbase, voff) do { _Pragma("unroll") for (int _i = 0; _i < 2; ++_i) \
        __builtin_amdgcn_global_load_lds((const unsigned*)((const char*)(gbase) + (voff)[_i]), (LAS unsigned*)(lds + (bufoff) + ldsw + _i * 8192), 16, 0, 0); } while (0)
#define PG8_LDA(dst, b, h) do { _Pragma("unroll") for (int m = 0; m < 4; ++m) _Pragma("unroll") for (int k = 0; k < 2; ++k) dst[m][k] = *(const LAS bf16x8*)(lds + PG8_SA(b, h) + aoff + m * 2048 + k * 1024); } while (0)
#define PG8_LDB(dst, b, h) do { _Pragma("unroll") for (int n = 0; n < 2; ++n) _Pragma("unroll") for (int k = 0; k < 2; ++k) dst[n][k] = *(const LAS bf16x8*)(lds + PG8_SB(b, h) + boff + n * 2048 + k * 1024); } while (0)
#define PG8_MMA(ai, bj, At, Bt) do { __builtin_amdgcn_s_setprio(1); _Pragma("unroll") for (int m = 0; m < 4; ++m) _Pragma("unroll") for (int n = 0; n < 2; ++n) _Pragma("unroll") for (int k = 0; k < 2; ++k) \
        acc[ai][bj][m][n] = __builtin_amdgcn_mfma_f32_16x16x32_bf16(Bt[n][k], At[m][k], acc[ai][bj][m][n], 0, 0, 0); __builtin_amdgcn_s_setprio(0); } while (0)
#define PG8_WAIT_V(n) asm volatile("s_waitcnt vmcnt(" #n ")" ::: "memory")
#define PG8_WAIT_L(n) asm volatile("s_waitcnt lgkmcnt(" #n ")" ::: "memory")
#define PG8_BAR __builtin_amdgcn_s_barrier()
#define PG8_SCHED __builtin_amdgcn_sched_barrier(0)
#define PG8_ABASE(u) ((const char*)((u).z ? g.A2 : g.A) + (size_t)(u).pm * tstep)
#define PG8_BBASE(u) ((const char*)((u).z ? g.Bt2 : g.Bt) + (size_t)(u).pn * tstep)
    Unit cur, nxt; int ui = 0;
    if (!S.next(0, cur)) return;
    f32x4 acc[2][2][4][2];
#pragma unroll
    for (int a = 0; a < 2; ++a)
#pragma unroll
        for (int b = 0; b < 2; ++b)
#pragma unroll
            for (int m = 0; m < 4; ++m)
#pragma unroll
                for (int n = 0; n < 2; ++n) acc[a][b][m][n] = (f32x4){0.f, 0.f, 0.f, 0.f};
    bf16x8 At[4][2], B0[2][2], B1[2][2];
    const char* cA = PG8_ABASE(cur); const char* cB = PG8_BBASE(cur);
    PG8_STAGE(PG8_SB(0, 0), cB, voffB); PG8_STAGE(PG8_SA(0, 0), cA, voffA); PG8_STAGE(PG8_SB(0, 1), cB + hstep, voffB); PG8_STAGE(PG8_SA(0, 1), cA + hstep, voffA);
    if (wr == 1) PG8_BAR;
    PG8_WAIT_V(4); PG8_BAR;
    PG8_STAGE(PG8_SB(1, 0), cB + kstep, voffB); PG8_STAGE(PG8_SA(1, 0), cA + kstep, voffA); PG8_STAGE(PG8_SB(1, 1), cB + hstep + kstep, voffB);
    PG8_WAIT_V(6); PG8_BAR;
    for (;;) {
        const bool has_next = S.next(ui + 1, nxt);
        const char* nA = has_next ? PG8_ABASE(nxt) : cA; const char* nB = has_next ? PG8_BBASE(nxt) : cB;
        for (int t = 0; t < nt; t += 2) {
            const bool last = (t == nt - 2);
            const char* a1 = cA + (size_t)(t + 1) * kstep;
            const char* a2 = last ? nA : cA + (size_t)(t + 2) * kstep; const char* b2 = last ? nB : cB + (size_t)(t + 2) * kstep;
            const char* a3 = a2 + kstep; const char* b3 = b2 + kstep;
            PG8_LDB(B0, 0, 0); PG8_SCHED; PG8_LDA(At, 0, 0); PG8_STAGE(PG8_SA(1, 1), a1 + hstep, voffA);
            PG8_WAIT_L(8); PG8_BAR; PG8_WAIT_L(0); PG8_MMA(0, 0, At, B0); PG8_BAR; PG8_SCHED;
            PG8_LDB(B1, 0, 1); PG8_STAGE(PG8_SB(0, 0), b2, voffB);
            PG8_BAR; PG8_WAIT_L(0); PG8_MMA(0, 1, At, B1); PG8_BAR;
            PG8_LDA(At, 0, 1); PG8_STAGE(PG8_SA(0, 0), a2, voffA);
            PG8_BAR; PG8_WAIT_L(0); PG8_MMA(1, 0, At, B0); PG8_BAR; PG8_SCHED;
            PG8_STAGE(PG8_SB(0, 1), b2 + hstep, voffB);
            PG8_WAIT_V(6); PG8_BAR; PG8_MMA(1, 1, At, B1); PG8_BAR;
            PG8_LDB(B0, 1, 0); PG8_SCHED; PG8_LDA(At, 1, 0); PG8_STAGE(PG8_SA(0, 1), a2 + hstep, voffA);
            PG8_WAIT_L(8); PG8_BAR; PG8_WAIT_L(0); PG8_MMA(0, 0, At, B0); PG8_BAR; PG8_SCHED;
            PG8_LDB(B1, 1, 1); PG8_STAGE(PG8_SB(1, 0), b3, voffB);
            PG8_BAR; PG8_WAIT_L(0); PG8_MMA(0, 1, At, B1); PG8_BAR;
            PG8_LDA(At, 1, 1); PG8_STAGE(PG8_SA(1, 0), a3, voffA);
            PG8_BAR; PG8_WAIT_L(0); PG8_MMA(1, 0, At, B0); PG8_BAR; PG8_SCHED;
            PG8_STAGE(PG8_SB(1, 1), b3 + hstep, voffB);
            PG8_WAIT_V(6); PG8_BAR; PG8_MMA(1, 1, At, B1); PG8_BAR;
        }
        const bool keep = E(acc, cur, wr, wc, fr, fq);
        if (!has_next) break;
        if (!keep) {
#pragma unroll
        for (int a = 0; a < 2; ++a)
#pragma unroll
            for (int b = 0; b < 2; ++b)
#pragma unroll
                for (int m = 0; m < 4; ++m)
#pragma unroll
                    for (int n = 0; n < 2; ++n) acc[a][b][m][n] = (f32x4){0.f, 0.f, 0.f, 0.f};
        }
        cur = nxt; cA = nA; cB = nB; ++ui;
    }
    PG8_WAIT_V(0);
    if (wr == 0) PG8_BAR;
    PG8_BAR;
#undef PG8_SA
#undef PG8_SB
#undef PG8_STAGE
#undef PG8_LDA
#undef PG8_LDB
#undef PG8_MMA
#undef PG8_WAIT_V
#undef PG8_WAIT_L
#undef PG8_BAR
#undef PG8_SCHED
#undef PG8_ABASE
#undef PG8_BBASE
}
}

struct EpiP {
    static constexpr bool PERM = true;
    bf16_t* O;
    DI bool operator()(const f32x4 (&acc)[2][2][4][2], const pg8::Unit& u, int wr, int wc, int fr, int fq) const {
        const int row0 = u.pm * 256 + wr * 64 + fr, col0 = u.pn * 256 + wc * 32 + 8 * fq;
        const bool hq = (u.pn >= C_HQ / 256) && (u.pn < C_FF / 256);
#pragma unroll
        for (int ai = 0; ai < 2; ++ai)
#pragma unroll
            for (int m = 0; m < 4; ++m) { bf16_t* rowp = O + pix(row0 + ai * 128 + m * 16, col0);
#pragma unroll
                for (int bj = 0; bj < 2; ++bj) { f32x4 v0 = acc[ai][bj][m][0], v1 = acc[ai][bj][m][1];
                    if (hq) {
#pragma unroll
                        for (int e = 0; e < 4; ++e) { v0[e] = siluf_(v0[e]); v1[e] = siluf_(v1[e]); } }
                    u32x4 w; w.x = cvt_pk_bf16(v0[0], v0[1]); w.y = cvt_pk_bf16(v0[2], v0[3]); w.z = cvt_pk_bf16(v1[0], v1[1]); w.w = cvt_pk_bf16(v1[2], v1[3]);
                    *(u32x4*)(rowp + bj * 128) = w; } }
        return false;
    }
};
DI int ctx_pn(int j) { return j < 8 ? 8 + j : (j < 16 ? 8 + j : 24 + j); }
struct CtxOrder {
    int c, G;
    DI bool next(int i, pg8::Unit& u) const { const int id = c + i * G; if (id >= 160) return false; const int t = id >> 1; u.pm = 64 + t / 40; u.pn = ctx_pn(t % 40); u.z = id & 1; return true; }
};
struct EpiCtx {
    static constexpr bool PERM = false;
    float* SC;
    DI bool operator()(const f32x4 (&acc)[2][2][4][2], const pg8::Unit& u, int wr, int wc, int fr, int fq) const {
        const int pnj = u.pn < 24 ? u.pn - 8 : u.pn - 24;
        float* base = SC + ((size_t)(u.z * 80 + (u.pm - 64) * 40 + pnj)) * 65536 + (size_t)(wr * 64 + fr) * 256 + wc * 32 + 4 * fq;
#pragma unroll
        for (int ai = 0; ai < 2; ++ai)
#pragma unroll
            for (int m = 0; m < 4; ++m)
#pragma unroll
                for (int bj = 0; bj < 2; ++bj)
#pragma unroll
                    for (int n = 0; n < 2; ++n) *(f32x4*)(base + (size_t)(ai * 128 + m * 16) * 256 + bj * 128 + n * 16) = acc[ai][bj][m][n];
        return false;
    }
};
DI void ctx_combine(const Params& p, const float* SC, bf16_t* P) {
    const int total = 80 * 8192;
    for (int e = blockIdx.x * NTHREADS + threadIdx.x; e < total; e += gridDim.x * NTHREADS) {
        const int t = e >> 13, w8 = (e & 8191) * 8, row = w8 >> 8, col = w8 & 255;
        const float* a = SC + (size_t)t * 65536 + w8; const float* b = a + (size_t)80 * 65536;
        const f32x4 a0 = *(const f32x4*)a, a1 = *(const f32x4*)(a + 4), b0 = *(const f32x4*)b, b1 = *(const f32x4*)(b + 4);
        const f32x4 s0 = a0 + b0, s1 = a1 + b1;
        u32x4 w; w.x = cvt_pk_bf16(s0[0], s0[1]); w.y = cvt_pk_bf16(s0[2], s0[3]); w.z = cvt_pk_bf16(s1[0], s1[1]); w.w = cvt_pk_bf16(s1[2], s1[3]);
        *(u32x4*)(P + pix((64 + t / 40) * 256 + row, ctx_pn(t % 40) * 256 + col)) = w;
    }
}
struct EpiM {
    static constexpr bool PERM = true;
    const bf16_t* P; bf16_t* Mo;
    DI bool operator()(f32x4 (&acc)[2][2][4][2], const pg8::Unit& u, int wr, int wc, int fr, int fq) const {
        const int row0 = u.pm * 256 + wr * 64 + fr, col0 = u.pn * 256 + wc * 32 + 8 * fq;
        const bool z0 = (u.z == 0);
#pragma unroll
        for (int ai = 0; ai < 2; ++ai) {
            u32x4 gbv[4][2], gav[4][2];
#pragma unroll
            for (int m = 0; m < 4; ++m) { const int row = row0 + ai * 128 + m * 16;
                const bf16_t* pgb = P + pix(row, C_GB + col0); const bf16_t* pga = P + pix(row, C_GA + col0);
#pragma unroll
                for (int bj = 0; bj < 2; ++bj) { gbv[m][bj] = *(const u32x4*)(pgb + bj * 128); if (z0) gav[m][bj] = *(const u32x4*)(pga + bj * 128); else gav[m][bj] = gbv[m][bj]; } }
            __builtin_amdgcn_sched_barrier(0);
#pragma unroll
            for (int m = 0; m < 4; ++m) { const int row = row0 + ai * 128 + m * 16;
#pragma unroll
                for (int bj = 0; bj < 2; ++bj) {
                    const u32x4 gb = gbv[m][bj];
                    if (z0) {
                        const u32x4 ga = gav[m][bj];
#pragma unroll
                        for (int e = 0; e < 4; ++e) {
                            const float a0 = bflo(ga[e]), a1 = bfhi(ga[e]), b0 = bflo(gb[e]), b1 = bfhi(gb[e]);
                            const float r0 = (1.0f + __expf(-b0)) * __builtin_amdgcn_rcpf(1.0f + __expf(-a0)), r1 = (1.0f + __expf(-b1)) * __builtin_amdgcn_rcpf(1.0f + __expf(-a1));
                            acc[ai][bj][m][e >> 1][(e & 1) * 2] *= r0; acc[ai][bj][m][e >> 1][(e & 1) * 2 + 1] *= r1; }
                    } else {
                        u32x4 w;
#pragma unroll
                        for (int e = 0; e < 4; ++e) {
                            const float s0 = sigmoidf_(bflo(gb[e])), s1 = sigmoidf_(bfhi(gb[e]));
                            w[e] = cvt_pk_bf16(acc[ai][bj][m][e >> 1][(e & 1) * 2] * s0, acc[ai][bj][m][e >> 1][(e & 1) * 2 + 1] * s1); }
                        *(u32x4*)(Mo + (size_t)row * DM + col0 + bj * 128) = w;
                    } } }
            __builtin_amdgcn_sched_barrier(0);
        }
        return z0;
    }
};
struct EpiOut {
    static constexpr bool PERM = false;
    const float* x; const float* mod; float* out;
    DI bool operator()(const f32x4 (&acc)[2][2][4][2], const pg8::Unit& u, int wr, int wc, int fr, int fq) const {
        const int row0 = u.pm * 256 + wr * 64 + fr, col0 = u.pn * 256 + wc * 32 + 4 * fq;
        const float* gate = mod + (size_t)(u.pm >> 5) * 12288 + 8192;
        f32x4 gv[2][2];
#pragma unroll
        for (int bj = 0; bj < 2; ++bj)
#pragma unroll
            for (int n = 0; n < 2; ++n) gv[bj][n] = *(const f32x4*)(gate + col0 + bj * 128 + n * 16);
#pragma unroll
        for (int ai = 0; ai < 2; ++ai)
#pragma unroll
            for (int m = 0; m < 4; ++m) { const size_t off = (size_t)(row0 + ai * 128 + m * 16) * DM + col0;
#pragma unroll
                for (int bj = 0; bj < 2; ++bj)
#pragma unroll
                    for (int n = 0; n < 2; ++n) { const f32x4 xv = *(const f32x4*)(x + off + bj * 128 + n * 16);
                        *(f32x4*)(out + off + bj * 128 + n * 16) = xv * ALPHA_F + gv[bj][n] * acc[ai][bj][m][n]; } }
        return false;
    }
};

struct RowBlockOrder {
    int x, s;
    DI void init(int c) { x = c & 7; s = c >> 3; }
    DI bool next(int i, pg8::Unit& u) const { if (i >= 4) return false; u.z = 0; u.pm = 16 * i + 4 * (x & 3) + (s & 3); u.pn = 8 * (x >> 2) + (s >> 2); return true; }
};
struct EpiLnOut {
    static constexpr bool PERM = false;
    const float* x; const float* mod; const float* ln_g; const float* ln_b; float* out;
    unsigned long long* slots; unsigned* cnt; LAS unsigned char* ptab;
    DI bool operator()(f32x4 (&acc)[2][2][4][2], const pg8::Unit& u, int wr, int wc, int fr, int fq) const {
        typedef float f32x2v __attribute__((ext_vector_type(2)));
        int t_ = threadIdx.x; asm volatile("" : "+v"(t_));
        wr = t_ >> 8; wc = (t_ >> 6) & 3; fr = t_ & 15; fq = (t_ >> 4) & 3;
        const int pm = __builtin_amdgcn_readfirstlane(u.pm), pn = __builtin_amdgcn_readfirstlane(u.pn);
        const unsigned loff = (unsigned)(((wr * 64 + fr) * DM + wc * 32 + 4 * fq) * 4);
        const unsigned coff = (unsigned)((wc * 32 + 4 * fq) * 4);
        const char* xt = (const char*)(x + (size_t)pm * 256 * DM + pn * 256);
        char* ot = (char*)(out + (size_t)pm * 256 * DM + pn * 256);
        const char* gt = (const char*)(mod + (size_t)(pm >> 5) * 12288 + 8192 + pn * 256);
        {
            f32x4 gv[2][2];
#pragma unroll
            for (int bj = 0; bj < 2; ++bj)
#pragma unroll
                for (int n = 0; n < 2; ++n) gv[bj][n] = *(const f32x4*)(gt + coff + (bj * 128 + n * 16) * 4);
#pragma unroll
            for (int ai = 0; ai < 2; ++ai)
#pragma unroll
                for (int m = 0; m < 4; ++m) { const char* xr = xt + (size_t)(ai * 128 + m * 16) * DM * 4;
#pragma unroll
                    for (int bj = 0; bj < 2; ++bj)
#pragma unroll
                        for (int n = 0; n < 2; ++n) { const f32x4 xv = *(const f32x4*)(xr + loff + (bj * 128 + n * 16) * 4); acc[ai][bj][m][n] = xv * ALPHA_F + gv[bj][n] * acc[ai][bj][m][n]; }
                    asm volatile("" : "+v"(acc[ai][0][m][0]), "+v"(acc[ai][0][m][1]), "+v"(acc[ai][1][m][0]), "+v"(acc[ai][1][m][1]) :: "memory"); }
        }
        LAS f32x2v* Pt = (LAS f32x2v*)ptab;
#pragma unroll
        for (int ai = 0; ai < 2; ++ai)
#pragma unroll
            for (int m = 0; m < 4; ++m) { float s1 = 0.f, s2 = 0.f;
#pragma unroll
                for (int bj = 0; bj < 2; ++bj)
#pragma unroll
                    for (int n = 0; n < 2; ++n) { const f32x4 v = acc[ai][bj][m][n]; s1 += (v[0] + v[1]) + (v[2] + v[3]); s2 += (v[0] * v[0] + v[1] * v[1]) + (v[2] * v[2] + v[3] * v[3]); }
                s1 += __shfl_xor(s1, 16); s1 += __shfl_xor(s1, 32); s2 += __shfl_xor(s2, 16); s2 += __shfl_xor(s2, 32);
                if (fq == 0) Pt[(ai * 128 + wr * 64 + m * 16 + fr) * 4 + wc] = (f32x2v){s1, s2}; }
        asm volatile("s_waitcnt lgkmcnt(0)" ::: "memory"); __builtin_amdgcn_s_barrier(); asm volatile("" ::: "memory");
        unsigned long long* st = slots + (size_t)pm * 256 * 16;
        const int hl = t_ & 255;
        if (hl < 128) { const int rl = (hl >> 6) * 128 + wr * 64 + (hl & 63);
            const f32x2v a = Pt[rl * 4 + 0], b = Pt[rl * 4 + 1], c = Pt[rl * 4 + 2], d = Pt[rl * 4 + 3];
            const float S1 = (a.x + b.x) + (c.x + d.x), S2 = (a.y + b.y) + (c.y + d.y);
            __hip_atomic_store(st + (rl * 16 + pn), ((unsigned long long)__float_as_uint(S2) << 32) | __float_as_uint(S1), __ATOMIC_RELAXED, __HIP_MEMORY_SCOPE_AGENT); }
        asm volatile("s_waitcnt vmcnt(0)" ::: "memory");
        unsigned* mycnt = cnt + 64 * pm + 32 * wr;
        if ((t_ & 63) == 0) __hip_atomic_fetch_add(mycnt, 1u, __ATOMIC_RELAXED, __HIP_MEMORY_SCOPE_AGENT);
        { unsigned sp = 0;
          while ((unsigned)__builtin_amdgcn_readfirstlane(__hip_atomic_load(mycnt, __ATOMIC_RELAXED, __HIP_MEMORY_SCOPE_AGENT)) < 64u) { __builtin_amdgcn_s_sleep(2); if (++sp > (1u << 17)) break; } }
        __builtin_amdgcn_fence(__ATOMIC_ACQUIRE, "agent");
        asm volatile("s_waitcnt vmcnt(0)" ::: "memory");
        const unsigned soff = (unsigned)(((wr * 64 + fr) * 16 + fq * 4) * 8);
        const char* lgt = (const char*)(ln_g + pn * 256); const char* lbt = (const char*)(ln_b + pn * 256);
#pragma unroll
        for (int ai = 0; ai < 2; ++ai)
#pragma unroll
            for (int m = 0; m < 4; ++m) {
                const char* sr = (const char*)st + (size_t)(ai * 128 + m * 16) * 16 * 8;
                float t1 = 0.f, t2 = 0.f;
#pragma unroll
                for (int t = 0; t < 4; ++t) { const unsigned long long w = __hip_atomic_load((const unsigned long long*)(sr + soff + t * 8), __ATOMIC_RELAXED, __HIP_MEMORY_SCOPE_AGENT); t1 += __uint_as_float((unsigned)w); t2 += __uint_as_float((unsigned)(w >> 32)); }
                t1 += __shfl_xor(t1, 16); t1 += __shfl_xor(t1, 32); t2 += __shfl_xor(t2, 16); t2 += __shfl_xor(t2, 32);
                const float mean = t1 * (1.0f / 4096.0f), var = fmaxf(t2 * (1.0f / 4096.0f) - mean * mean, 0.f), rstd = rsqrtf(var + 1e-6f);
                char* orow = ot + (size_t)(ai * 128 + m * 16) * DM * 4;
#pragma unroll
                for (int bj = 0; bj < 2; ++bj)
#pragma unroll
                    for (int n = 0; n < 2; ++n) { const f32x4 gg = *(const f32x4*)(lgt + coff + (bj * 128 + n * 16) * 4), bb = *(const f32x4*)(lbt + coff + (bj * 128 + n * 16) * 4);
                        *(f32x4*)(orow + loff + (bj * 128 + n * 16) * 4) = (acc[ai][bj][m][n] - mean) * rstd * gg + bb; }
                asm volatile("" ::: "memory"); }
        return false;
    }
};

DI void phase_adaln(const Params& p, float* mod, unsigned char* lds) {
    float* sc = (float*)lds;
    float* red = sc + 3 * 4096;
    const int tid = threadIdx.x;
    if ((int)blockIdx.x < 384) {
        for (int i = tid; i < 3 * 4096; i += NTHREADS) { const float v = (i < 8192) ? p.c[i] : p.c_ctx[i - 8192]; sc[i] = siluf_(v); }
    }
    __syncthreads();
    for (int item = blockIdx.x; item < 384; item += gridDim.x) {
        const int c4 = tid & 7, rg = tid >> 3, col = item * 32 + c4 * 4;
        f32x4 a0 = (f32x4){0.f, 0.f, 0.f, 0.f}, a1 = a0, a2 = a0;
#pragma unroll 8
        for (int r = rg; r < 4096; r += 64) { const f32x4 w = *(const f32x4*)(p.w_ada + (size_t)r * 12288 + col); a0 += w * sc[r]; a1 += w * sc[4096 + r]; a2 += w * sc[8192 + r]; }
#pragma unroll
        for (int e = 0; e < 4; ++e) { red[(rg * 3 + 0) * 32 + c4 * 4 + e] = a0[e]; red[(rg * 3 + 1) * 32 + c4 * 4 + e] = a1[e]; red[(rg * 3 + 2) * 32 + c4 * 4 + e] = a2[e]; }
        __syncthreads();
        if (tid < 96) { const int cnd = tid >> 5, c2 = tid & 31; float s2 = 0.f;
            for (int g = 0; g < 64; ++g) s2 += red[(g * 3 + cnd) * 32 + c2];
            mod[cnd * 12288 + item * 32 + c2] = s2 + p.b_ada[item * 32 + c2]; }
        __syncthreads();
    }
}
DI void transpose_tile(const float* src, bf16_t* dst, int K, int N, int kt, int nt, float* tl) {
    const int tid = threadIdx.x;
#pragma unroll
    for (int i = 0; i < 4; ++i) { const int row = (tid >> 4) + 32 * i, c4 = (tid & 15) * 4;
        const f32x4 v = *(const f32x4*)(src + (size_t)(kt * 128 + row) * N + nt * 64 + c4);
        tl[row * 65 + c4 + 0] = v[0]; tl[row * 65 + c4 + 1] = v[1]; tl[row * 65 + c4 + 2] = v[2]; tl[row * 65 + c4 + 3] = v[3]; }
    __syncthreads();
    { const int n = tid >> 3, kc = tid & 7; u32x4 w0, w1;
#pragma unroll
      for (int j = 0; j < 4; ++j) { w0[j] = cvt_pk_bf16(tl[(kc * 16 + 2 * j) * 65 + n], tl[(kc * 16 + 2 * j + 1) * 65 + n]);
                                    w1[j] = cvt_pk_bf16(tl[(kc * 16 + 8 + 2 * j) * 65 + n], tl[(kc * 16 + 8 + 2 * j + 1) * 65 + n]); }
      bf16_t* d = dst + (size_t)(nt * 64 + n) * K + kt * 128 + kc * 16;
      *(u32x4*)d = w0; *(u32x4*)(d + 8) = w1; }
    __syncthreads();
}
DI void phase_weights(const Params& p, unsigned char* lds) {
    float* tl = (float*)lds;
    bf16_t* WinT = (bf16_t*)(p.ws + WS_WIN); bf16_t* WpaT = (bf16_t*)(p.ws + WS_WPA); bf16_t* WpbT = (bf16_t*)(p.ws + WS_WPB); bf16_t* WoutT = (bf16_t*)(p.ws + WS_WOUT);
    constexpr int T_IN = 32 * 416, T_PA = 16 * 64, T_OUT = 32 * 64;
    for (int it = blockIdx.x; it < T_IN + 2 * T_PA + T_OUT; it += gridDim.x) {
        if (it < T_IN) transpose_tile(p.w_in, WinT, 4096, NIN, it / 416, it % 416, tl);
        else if (it < T_IN + T_PA) { const int j = it - T_IN; transpose_tile(p.w_pa, WpaT, 2048, 4096, j / 64, j % 64, tl); }
        else if (it < T_IN + 2 * T_PA) { const int j = it - T_IN - T_PA; transpose_tile(p.w_pb, WpbT, 2048, 4096, j / 64, j % 64, tl); }
        else { const int j = it - T_IN - 2 * T_PA; transpose_tile(p.w_out, WoutT, 4096, 4096, j / 64, j % 64, tl); }
    }
}

DI void phase_ln_mod(const Params& p, const float* mod, bf16_t* H) {
    const int wave = threadIdx.x >> 6, lane = threadIdx.x & 63;
    for (int row = blockIdx.x * 8 + wave; row < MROWS; row += gridDim.x * 8) {
        const float* src; int cnd;
        if (row < NLAT) { src = p.x + (size_t)row * DM; cnd = row >> 13; } else { src = p.ctx + (size_t)(row - NLAT) * DM; cnd = 2; }
        f32x4 v[16]; float s = 0.f;
#pragma unroll
        for (int i = 0; i < 16; ++i) { v[i] = ((const f32x4*)src)[i * 64 + lane]; s += (v[i][0] + v[i][1]) + (v[i][2] + v[i][3]); }
        s = wave_sum(s); const float mean = s * (1.0f / 4096.0f);
        float q = 0.f;
#pragma unroll
        for (int i = 0; i < 16; ++i) { const f32x4 d = v[i] - mean; q += (d[0] * d[0] + d[1] * d[1]) + (d[2] * d[2] + d[3] * d[3]); }
        q = wave_sum(q); const float rstd = rsqrtf(q * (1.0f / 4096.0f) + 1e-6f);
        const float* shift = mod + cnd * 12288; const float* scale = shift + 4096;
#pragma unroll
        for (int i = 0; i < 16; ++i) { const int col = (i * 64 + lane) * 4;
            const f32x4 sh = *(const f32x4*)(shift + col), sc = *(const f32x4*)(scale + col);
            const f32x4 hh = (v[i] - mean) * rstd * (sc + 1.0f) + sh;
            u32x2 w; w.x = cvt_pk_bf16(hh[0], hh[1]); w.y = cvt_pk_bf16(hh[2], hh[3]);
            *(u32x2*)(H + (size_t)row * DM + col) = w; }
    }
}

constexpr size_t WS_DEC = (size_t)2 * NLAT * 2048 * 4;
constexpr size_t WS_KUF = WS_DEC + (size_t)64 * 132 * 128 * 4;
constexpr size_t WS_KUC = WS_KUF + (size_t)32 * 128 * 16384;
static_assert(WS_KUC + (size_t)64 * 4 * 16384 <= WS_P, "hgrn scratch must fit before P");
DI float rcpf_(float v) { return __builtin_amdgcn_rcpf(v); }
DI unsigned char* hg_kut(const Params& p, int dir, int q, int n) {
    if (n < 4) return p.ws + WS_KUC + (size_t)((dir * 32 + q) * 4 + n) * 16384;
    return p.ws + (dir ? WS_YB : WS_KUF) + (size_t)(q * 128 + (n - 4)) * 16384;
}
DI unsigned char* hg_qc(const Params& p, int dir, int q, int n) { return p.ws + WS_M + (size_t)((dir * 32 + q) * 128 + (n - 4)) * 16384; }
DI float* hg_dec(const Params& p, int dir, int q, int n) { return (float*)(p.ws + WS_DEC) + (size_t)((dir * 32 + q) * 132 + n) * 128; }
#define HG_ROW0(n, b, dir, r0, sg) { int base_, len_, cn_; if ((n) < 4) { base_ = NLAT + (b) * LC; len_ = LC; cn_ = (n); } else { base_ = (b) * TT; len_ = TT; cn_ = (n) - 4; } \
        if (dir) { r0 = base_ + len_ - 1 - cn_ * 64; sg = -1; } else { r0 = base_ + cn_ * 64; sg = 1; } }

DI void hgrn_h1(const Params& p, unsigned char* lds) {
    const int tid = threadIdx.x, lane = tid & 63, w = tid >> 6, g = lane >> 4, c16 = lane & 15;
    const bf16_t* P = (const bf16_t*)(p.ws + WS_P);
    bf16_t* O = (bf16_t*)(p.ws + WS_O);
    bf16_t* Qa = (bf16_t*)lds;
    bf16_t* Kb = Qa + 64 * 136;
    bf16_t* Qc = Kb + 64 * 136;
    bf16_t* Vs = Qc + 64 * 136;
    bf16_t* Kut = Vs + 64 * 136;
    bf16_t* Am = Kut + 128 * 72;
    float* segtot = (float*)(Am + 64 * 72);
    LAS unsigned char* l3 = (LAS unsigned char*)lds;
    const unsigned vsb = 3 * 17408;
    const int d = tid & 127, seg = tid >> 7;
    const int lk0 = tid >> 4, ld8 = (tid & 15) * 8;
    const int ib = w >> 1, trq = c16 >> 2, trp = c16 & 3;
    bf16_t fraw[16], qraw[16]; u32x4 vraw[2];
#define H1_LOAD(it_) { const int n_ = (it_) % 132, sq_ = (it_) / 132, dir_ = sq_ & 1, q_ = sq_ >> 1, h_ = q_ & 15, b_ = q_ >> 4; int r0_, sg_; HG_ROW0(n_, b_, dir_, r0_, sg_); \
        const int colF_ = (dir_ ? C_FB : C_FF) + h_ * 128 + d, colQ_ = C_HQ + h_ * 128 + d; \
        _Pragma("unroll") for (int jj = 0; jj < 16; ++jj) { const int ro = r0_ + sg_ * (seg * 16 + jj); fraw[jj] = P[pix(ro, colF_)]; if (n_ >= 4) qraw[jj] = P[pix(ro, colQ_)]; } \
        if (n_ >= 4) { _Pragma("unroll") for (int i2 = 0; i2 < 2; ++i2) vraw[i2] = *(const u32x4*)(P + pix(r0_ + sg_ * (lk0 + 32 * i2), C_HI + h_ * 128 + ld8)); } }
    int it = blockIdx.x;
    if (it < 8448) H1_LOAD(it);
    for (; it < 8448; it += gridDim.x) {
        const int n = it % 132, sq = it / 132, dir = sq & 1, q = sq >> 1, h = q & 15, b = q >> 4;
        const bool lat = n >= 4;
        float lb;
        { const float* lbp = dir ? p.lb_bwd : p.lb_fwd; const float l0 = lbp[h * 128 + d], l1 = lbp[2048 + h * 128 + d]; lb = rcpf_(1.0f + __expf(l1 - l0)); }
        const float omlb = 1.0f - lb;
        float cl[16], kk[16], qs[16];
        float run = 1.f;
#pragma unroll
        for (int jj = 0; jj < 16; ++jj) { const float f = bf2f(fraw[jj]); const float sgm = rcpf_(1.0f + __expf(-f));
            kk[jj] = omlb * (1.0f - sgm); run *= lb + omlb * sgm; cl[jj] = run;
            qs[jj] = lat ? bf2f(qraw[jj]) : 0.f; }
        const u32x4 v0 = vraw[0], v1 = vraw[1];
        segtot[seg * 128 + d] = run;
        if (it + (int)gridDim.x < 8448) H1_LOAD(it + (int)gridDim.x);
        __syncthreads();
        {
            const float t0 = segtot[d], t1 = segtot[128 + d], t2 = segtot[256 + d], t3 = segtot[384 + d];
            const float ref = t0 * t1, elr = t2 * t3, last = ref * elr;
            const float offs = (seg == 0) ? 1.f : (seg == 1) ? t0 : (seg == 2) ? ref : ref * t2;
            const float rref = rcpf_(ref);
            unsigned kup[8];
#pragma unroll
            for (int jj = 0; jj < 16; jj += 2) {
                const float c0 = offs * cl[jj], c1 = offs * cl[jj + 1];
                const float e0 = c0 * rref, e1 = c1 * rref;
                const float i0 = ref * rcpf_(c0), i1 = ref * rcpf_(c1);
                kup[jj >> 1] = cvt_pk_bf16(kk[jj] * i0 * elr, kk[jj + 1] * i1 * elr);
                if (lat) {
                    const int r0 = (seg * 16 + jj) * 136 + d, r1 = r0 + 136;
                    const unsigned wa = cvt_pk_bf16(qs[jj] * e0, qs[jj + 1] * e1), wc2 = cvt_pk_bf16(qs[jj] * c0, qs[jj + 1] * c1), wk = cvt_pk_bf16(kk[jj] * i0, kk[jj + 1] * i1);
                    Qa[r0] = (bf16_t)(wa & 0xffffu); Qa[r1] = (bf16_t)(wa >> 16);
                    Qc[r0] = (bf16_t)(wc2 & 0xffffu); Qc[r1] = (bf16_t)(wc2 >> 16);
                    Kb[r0] = (bf16_t)(wk & 0xffffu); Kb[r1] = (bf16_t)(wk >> 16); }
            }
            *(u32x4*)(Kut + d * 72 + seg * 16) = (u32x4){kup[0], kup[1], kup[2], kup[3]};
            *(u32x4*)(Kut + d * 72 + seg * 16 + 8) = (u32x4){kup[4], kup[5], kup[6], kup[7]};
            if (seg == 0) hg_dec(p, dir, q, n)[d] = last;
            if (lat) { *(u32x4*)(Vs + lk0 * 136 + ld8) = v0; *(u32x4*)(Vs + (lk0 + 32) * 136 + ld8) = v1; }
        }
        __syncthreads();
        {
            bf16_t* kg = (bf16_t*)hg_kut(p, dir, q, n);
#pragma unroll
            for (int i2 = 0; i2 < 2; ++i2) { const int ch = tid + 512 * i2, row = ch >> 3, c8 = (ch & 7) * 8; *(u32x4*)(kg + row * 64 + c8) = *(const u32x4*)(Kut + row * 72 + c8); }
            if (lat) { bf16_t* qg = (bf16_t*)hg_qc(p, dir, q, n);
#pragma unroll
                for (int i2 = 0; i2 < 2; ++i2) { const int ch = tid + 512 * i2, row = ch >> 4, c8 = (ch & 15) * 8; *(u32x4*)(qg + row * 128 + c8) = *(const u32x4*)(Qc + row * 136 + c8); } }
        }
        if (lat) {
#pragma unroll
            for (int q2 = 0; q2 < 2; ++q2) { const int sb = (w & 1) * 2 + q2;
                f32x4 a = (f32x4){0.f, 0.f, 0.f, 0.f};
                if (sb <= ib) {
#pragma unroll
                    for (int ks = 0; ks < 4; ++ks) { const bf16x8 fa = *(const bf16x8*)(Qa + (ib * 16 + c16) * 136 + ks * 32 + g * 8), fb = *(const bf16x8*)(Kb + (sb * 16 + c16) * 136 + ks * 32 + g * 8);
                        a = MFMA16(fa, fb, a); }
                }
#pragma unroll
                for (int j = 0; j < 4; ++j) { const int ii = ib * 16 + g * 4 + j, ss = sb * 16 + c16; Am[ii * 72 + ss] = f2bf((ss <= ii) ? a[j] : 0.f); }
            }
        }
        __syncthreads();
        if (lat) {
            int r0, sg; HG_ROW0(n, b, dir, r0, sg);
#pragma unroll
            for (int cc = 0; cc < 4; ++cc) { const int c = (w & 1) * 4 + cc;
                f32x4 o = (f32x4){0.f, 0.f, 0.f, 0.f};
#pragma unroll
                for (int ks = 0; ks < 2; ++ks) {
                    if (ks == 1 && ib < 2) continue;
                    const bf16x8 fa = *(const bf16x8*)(Am + (ib * 16 + c16) * 72 + ks * 32 + g * 8);
                    const s16x4 lo = __builtin_amdgcn_ds_read_tr16_b64_v4i16((LAS s16x4*)(l3 + vsb + (32 * ks + 8 * g + trq) * 272 + 32 * c + 8 * trp));
                    const s16x4 hi = __builtin_amdgcn_ds_read_tr16_b64_v4i16((LAS s16x4*)(l3 + vsb + (32 * ks + 8 * g + 4 + trq) * 272 + 32 * c + 8 * trp));
                    o = MFMA16(__builtin_shufflevector(lo, hi, 0, 1, 2, 3, 4, 5, 6, 7), fa, o); }
                u32x2 ow;
                ow.x = (unsigned)f2bf(o[0]) | ((unsigned)f2bf(o[1]) << 16); ow.y = (unsigned)f2bf(o[2]) | ((unsigned)f2bf(o[3]) << 16);
                *(u32x2*)(O + oix(dir, r0 + sg * (ib * 16 + c16), h, c * 16 + 4 * g)) = ow;
            }
        }
    }
    __syncthreads();
#undef H1_LOAD
}

DI void hgrn_h2(const Params& p, int it, unsigned char* lds) {
    const int tid = threadIdx.x, lane = tid & 63, w = tid >> 6, g = lane >> 4, c16 = lane & 15;
    const int dvq = it & 3, dir = (it >> 2) & 1, h = (it >> 3) & 15, b = it >> 7, q = b * 16 + h;
    const bf16_t* P = (const bf16_t*)(p.ws + WS_P);
    bf16_t* O = (bf16_t*)(p.ws + WS_O);
    bf16_t* L = (bf16_t*)lds;
    LAS unsigned char* l3 = (LAS unsigned char*)lds;
    bf16_t* Stb = (bf16_t*)(lds + 81920);
    const int ib = w >> 1, vb = w & 1, trq = c16 >> 2, trp = c16 & 3;
    const int vs = tid >> 2, vc8 = (tid & 3) * 8;
    for (int i = tid; i < 2 * 32 * 136; i += NTHREADS) Stb[i] = 0;
    f32x4 Sreg[2]; Sreg[0] = (f32x4){0.f, 0.f, 0.f, 0.f}; Sreg[1] = Sreg[0];
    u32x4 kur[2], qcr[2], vqr; float decr[2], decc[2]; u32x2 oinr, oinc;
#define H2_LOAD(n_) { int r0_, sg_; HG_ROW0(n_, b, dir, r0_, sg_); \
        const bf16_t* kg_ = (const bf16_t*)hg_kut(p, dir, q, n_); \
        _Pragma("unroll") for (int i2 = 0; i2 < 2; ++i2) { const int ch = tid + 512 * i2; kur[i2] = *(const u32x4*)(kg_ + (ch >> 3) * 64 + (ch & 7) * 8); } \
        if (tid < 256) vqr = *(const u32x4*)(P + pix(r0_ + sg_ * vs, C_HI + h * 128 + dvq * 32 + vc8)); \
        const float* dg_ = hg_dec(p, dir, q, n_); decr[0] = dg_[((w >> 1) * 2) * 16 + c16]; decr[1] = dg_[((w >> 1) * 2 + 1) * 16 + c16]; \
        if ((n_) >= 4) { const bf16_t* qg_ = (const bf16_t*)hg_qc(p, dir, q, n_); \
            _Pragma("unroll") for (int i2 = 0; i2 < 2; ++i2) { const int ch = tid + 512 * i2; qcr[i2] = *(const u32x4*)(qg_ + (ch >> 4) * 128 + (ch & 15) * 8); } \
            oinr = *(const u32x2*)(O + oix(dir, r0_ + sg_ * (ib * 16 + c16), h, dvq * 32 + vb * 16 + 4 * g)); } }
#define H2_WRITE(bf_) { bf16_t* B_ = L + (bf_) * 20480; \
        _Pragma("unroll") for (int i2 = 0; i2 < 2; ++i2) { const int ch = tid + 512 * i2; *(u32x4*)(B_ + (ch >> 3) * 72 + (ch & 7) * 8) = kur[i2]; *(u32x4*)(B_ + 9216 + (ch >> 4) * 136 + (ch & 15) * 8) = qcr[i2]; } \
        if (tid < 256) *(u32x4*)(B_ + 9216 + 8704 + vs * 40 + vc8) = vqr; }
    qcr[0] = (u32x4){0u, 0u, 0u, 0u}; qcr[1] = qcr[0];
    H2_LOAD(0); H2_WRITE(0);
#pragma unroll
    for (int j = 0; j < 2; ++j) decc[j] = decr[j];
    oinr = (u32x2){0u, 0u}; oinc = oinr;
    H2_LOAD(1);
    __syncthreads();
    for (int n = 0; n < 132; ++n) {
        const int cur = n & 1;
        const bf16_t* Bc = L + cur * 20480;
        const bf16_t* KutS = Bc; const bf16_t* QcS = Bc + 9216;
        const unsigned vqb = (unsigned)(cur * 40960 + (9216 + 8704) * 2);
        const bf16_t* Sc = Stb + cur * 4352; bf16_t* Sn = Stb + (cur ^ 1) * 4352;
        f32x4 u[2];
#pragma unroll
        for (int q2 = 0; q2 < 2; ++q2) { const int db = (w >> 1) * 2 + q2; u[q2] = (f32x4){0.f, 0.f, 0.f, 0.f};
#pragma unroll
            for (int ks = 0; ks < 2; ++ks) {
                const s16x4 lo = __builtin_amdgcn_ds_read_tr16_b64_v4i16((LAS s16x4*)(l3 + vqb + (32 * ks + 8 * g + trq) * 80 + 32 * vb + 8 * trp));
                const s16x4 hi = __builtin_amdgcn_ds_read_tr16_b64_v4i16((LAS s16x4*)(l3 + vqb + (32 * ks + 8 * g + 4 + trq) * 80 + 32 * vb + 8 * trp));
                const bf16x8 fb = *(const bf16x8*)(KutS + (db * 16 + c16) * 72 + ks * 32 + g * 8);
                u[q2] = MFMA16(__builtin_shufflevector(lo, hi, 0, 1, 2, 3, 4, 5, 6, 7), fb, u[q2]); } }
        if (n >= 4) {
            f32x4 oacc = (f32x4){0.f, 0.f, 0.f, 0.f};
#pragma unroll
            for (int ks = 0; ks < 4; ++ks) { const bf16x8 fa = *(const bf16x8*)(QcS + (ib * 16 + c16) * 136 + ks * 32 + g * 8), fb = *(const bf16x8*)(Sc + (vb * 16 + c16) * 136 + ks * 32 + g * 8);
                oacc = MFMA16(fb, fa, oacc); }
            int r0, sg; HG_ROW0(n, b, dir, r0, sg);
            u32x2 ow; ow.x = cvt_pk_bf16(bflo(oinc.x) + oacc[0], bfhi(oinc.x) + oacc[1]); ow.y = cvt_pk_bf16(bflo(oinc.y) + oacc[2], bfhi(oinc.y) + oacc[3]);
            *(u32x2*)(O + oix(dir, r0 + sg * (ib * 16 + c16), h, dvq * 32 + vb * 16 + 4 * g)) = ow;
        }
#pragma unroll
        for (int q2 = 0; q2 < 2; ++q2) { const int db = (w >> 1) * 2 + q2;
            Sreg[q2] = Sreg[q2] * decc[q2] + u[q2];
#pragma unroll
            for (int j = 0; j < 4; ++j) Sn[(vb * 16 + g * 4 + j) * 136 + db * 16 + c16] = f2bf(Sreg[q2][j]); }
        if (n + 1 < 132) { H2_WRITE(cur ^ 1);
#pragma unroll
            for (int j = 0; j < 2; ++j) decc[j] = decr[j];
            oinc = oinr; }
        if (n + 2 < 132) H2_LOAD(n + 2);
        __syncthreads();
    }
#undef H2_LOAD
#undef H2_WRITE
}

typedef float f32x16 __attribute__((ext_vector_type(16)));
#define MFMA32(a, b, c) __builtin_amdgcn_mfma_f32_32x32x16_bf16((a), (b), (c), 0, 0, 0)
DI float xchg32(float v) {
    const unsigned u = __float_as_uint(v);
    const auto r = __builtin_amdgcn_permlane32_swap(u, u, false, false);
    return __uint_as_float((threadIdx.x & 32) ? r[0] : r[1]);
}
DI int clamp_rs(int r) { return min(max(r - 4, 0), 120); }
DI void attn_item(const Params& p, int it, unsigned char* lds) {
    const int tid = threadIdx.x, lane = tid & 63, w = tid >> 6, r32 = lane & 31, hh = lane >> 5;
    const int rq4 = it & 31, h = (it >> 5) & 15, b = it >> 9;
    const int cq = w & 3, rlo = 4 * rq4 + 2 * (w >> 2);
    const int rr = rlo + (r32 >> 4);
    const bf16_t* P = (const bf16_t*)(p.ws + WS_P);
    bf16_t* YA = (bf16_t*)(p.ws + WS_YA);
    bf16_t* KV = (bf16_t*)lds;
    LAS unsigned char* l3 = (LAS unsigned char*)lds;
    float* rp = (float*)(lds + 2 * 34816);
    const int rs0 = clamp_rs(4 * rq4), rs3 = clamp_rs(4 * rq4 + 3), nloc = rs3 + 8 - rs0, nt = nloc + 4;
    const int rsl = clamp_rs(rr);
    const int rsw0 = clamp_rs(rlo), rsw1 = clamp_rs(rlo + 1) + 8;
    for (int i = tid; i < 704; i += NTHREADS) rp[i] = (i >= 96 && i < 96 + 465) ? p.rpb[h * 465 + i - 96] * 1.4426950408889634f : 0.f;
    const int qc = 16 * cq + (r32 & 15), qrow = b * TT + rr * 64 + qc;
    const int cs = min(max(qc - 8, 0), 48);
    const int koff = min(max(16 * cq - 8, 0), 32);
    bf16x8 qf[8];
#pragma unroll
    for (int s2 = 0; s2 < 8; ++s2) qf[s2] = *(const bf16x8*)(P + pix(qrow, C_Q + h * 128 + 16 * s2 + 8 * hh));
    unsigned okmask = 0u;
#pragma unroll
    for (int k = 0; k < 16; ++k) { const int kc = koff + (k & 3) + 8 * (k >> 2) + 4 * hh; okmask |= ((kc >= cs) && (kc < cs + 16)) ? (1u << k) : 0u; }
    const int lk0 = tid >> 4, ld8 = (tid & 15) * 8;
    u32x4 kreg[2], vreg[2];
#define AT_LOAD(t) { const int rowb = ((t) < nloc) ? (b * TT + (rs0 + (t)) * 64) : (NLAT + b * LC + ((t) - nloc) * 64); \
        _Pragma("unroll") for (int i2 = 0; i2 < 2; ++i2) { const int kr_ = rowb + lk0 + 32 * i2; \
            kreg[i2] = *(const u32x4*)(P + pix(kr_, C_K + h * 128 + ld8)); vreg[i2] = *(const u32x4*)(P + pix(kr_, C_V + h * 128 + ld8)); } }
#define AT_WRITE(buf) { bf16_t* Kd = KV + (buf) * 17408; \
        _Pragma("unroll") for (int i2 = 0; i2 < 2; ++i2) { *(u32x4*)(Kd + (lk0 + 32 * i2) * 136 + ld8) = kreg[i2]; *(u32x4*)(Kd + 8704 + (lk0 + 32 * i2) * 136 + ld8) = vreg[i2]; } }
    AT_LOAD(0); AT_WRITE(0); AT_LOAD(1);
    float m_run = -1e30f, l_part = 0.f;
    f32x16 oa[4];
#pragma unroll
    for (int c = 0; c < 4; ++c)
#pragma unroll
        for (int i = 0; i < 16; ++i) oa[c][i] = 0.f;
    const float scale2 = 0.08838834764831845f * 1.4426950408889634f;
    const int blk = (lane >> 4) & 1, trq = (lane & 15) >> 2, trp = lane & 3;
    const unsigned troff = (unsigned)((4 * hh + trq) * 272 + 32 * blk + 8 * trp);
    __syncthreads();
    for (int t = 0; t < nt; ++t) {
        const bool local = t < nloc;
        const int kr = rs0 + t;
        const bool rowok = !local || ((kr >= rsw0) && (kr < rsw1));
        const int kbase = local ? koff : 0;
        const bf16_t* Ks = KV + (t & 1) * 17408 + kbase * 136;
        const unsigned vsb = (unsigned)((t & 1) * 34816 + 17408 + kbase * 272);
        if (rowok) {
            f32x16 sa[2];
            float bv[16];
            {
                bf16x8 kf[8];
#pragma unroll
                for (int s2 = 0; s2 < 8; ++s2) kf[s2] = *(const bf16x8*)(Ks + r32 * 136 + 16 * s2 + 8 * hh);
                if (local) {
                    const float* bp = rp + ((kr - rr + 7) * 31 + 111 - qc + koff + 4 * hh);
#pragma unroll
                    for (int k = 0; k < 16; ++k) bv[k] = bp[(k & 3) + 8 * (k >> 2)];
                } else {
#pragma unroll
                    for (int k = 0; k < 16; ++k) bv[k] = 0.f;
                }
                __builtin_amdgcn_sched_barrier(0);
#pragma unroll
                for (int i = 0; i < 16; ++i) { sa[0][i] = 0.f; sa[1][i] = 0.f; }
#pragma unroll
                for (int s2 = 0; s2 < 8; ++s2) sa[0] = MFMA32(kf[s2], qf[s2], sa[0]);
                if (!local) {
                    __builtin_amdgcn_sched_barrier(0);
#pragma unroll
                    for (int s2 = 0; s2 < 8; ++s2) kf[s2] = *(const bf16x8*)(Ks + (32 + r32) * 136 + 16 * s2 + 8 * hh);
                    __builtin_amdgcn_sched_barrier(0);
#pragma unroll
                    for (int s2 = 0; s2 < 8; ++s2) sa[1] = MFMA32(kf[s2], qf[s2], sa[1]);
                }
            }
            float mx = -INFINITY;
            if (local) {
                const bool lrow = (kr >= rsl) && (kr < rsl + 8);
                const unsigned om = lrow ? okmask : 0u;
#pragma unroll
                for (int i = 0; i < 16; ++i) {
                    const float v0 = sa[0][i] * scale2 + bv[i];
                    const float v = ((om >> i) & 1u) ? v0 : -INFINITY;
                    sa[0][i] = v; mx = fmaxf(mx, v); }
            } else {
#pragma unroll
                for (int kb = 0; kb < 2; ++kb)
#pragma unroll
                    for (int i = 0; i < 16; ++i) { const float v = sa[kb][i] * scale2; sa[kb][i] = v; mx = fmaxf(mx, v); }
            }
            mx = fmaxf(mx, xchg32(mx));
            const float m_new = fmaxf(m_run, mx), alpha = __builtin_amdgcn_exp2f(m_run - m_new);
            float lsum = 0.f;
#pragma unroll
            for (int i = 0; i < 16; ++i) { const float pv = __builtin_amdgcn_exp2f(sa[0][i] - m_new); sa[0][i] = pv; lsum += pv; }
            if (!local) {
#pragma unroll
                for (int i = 0; i < 16; ++i) { const float pv = __builtin_amdgcn_exp2f(sa[1][i] - m_new); sa[1][i] = pv; lsum += pv; } }
            l_part = l_part * alpha + lsum; m_run = m_new;
            if (__any(alpha != 1.0f)) {
#pragma unroll
                for (int c = 0; c < 4; ++c) oa[c] = oa[c] * alpha; }
#pragma unroll
            for (int kb = 0; kb < 2; ++kb) {
                if (kb == 1 && local) continue;
                bf16x8 pb[2];
#pragma unroll
                for (int s2 = 0; s2 < 2; ++s2) {
                    const u32x4 pw = (u32x4){cvt_pk_bf16(sa[kb][8 * s2 + 0], sa[kb][8 * s2 + 1]), cvt_pk_bf16(sa[kb][8 * s2 + 2], sa[kb][8 * s2 + 3]),
                                             cvt_pk_bf16(sa[kb][8 * s2 + 4], sa[kb][8 * s2 + 5]), cvt_pk_bf16(sa[kb][8 * s2 + 6], sa[kb][8 * s2 + 7])};
                    pb[s2] = __builtin_bit_cast(bf16x8, pw); }
                s16x4 tl[2][4], th[2][4];
#pragma unroll
                for (int s2 = 0; s2 < 2; ++s2)
#pragma unroll
                    for (int c = 0; c < 4; ++c) {
                        tl[s2][c] = __builtin_amdgcn_ds_read_tr16_b64_v4i16((LAS s16x4*)(l3 + vsb + troff + (32 * kb + 16 * s2) * 272 + 64 * c));
                        th[s2][c] = __builtin_amdgcn_ds_read_tr16_b64_v4i16((LAS s16x4*)(l3 + vsb + troff + (32 * kb + 16 * s2 + 8) * 272 + 64 * c)); }
                __builtin_amdgcn_sched_barrier(0);
#pragma unroll
                for (int s2 = 0; s2 < 2; ++s2)
#pragma unroll
                    for (int c = 0; c < 4; ++c) oa[c] = MFMA32(__builtin_shufflevector(tl[s2][c], th[s2][c], 0, 1, 2, 3, 4, 5, 6, 7), pb[s2], oa[c]);
            }
        }
        if (t + 1 < nt) AT_WRITE((t + 1) & 1);
        if (t + 2 < nt) AT_LOAD(t + 2);
        __syncthreads();
    }
    {
        const float inv = 1.0f / (l_part + xchg32(l_part));
        const size_t zo = pix(qrow, C_Z + h * 128); const size_t yo = (size_t)qrow * 2048 + h * 128;
#pragma unroll
        for (int c = 0; c < 4; ++c)
#pragma unroll
            for (int i4 = 0; i4 < 4; ++i4) { const int dv = 32 * c + 8 * i4 + 4 * hh;
                const u32x2 zz = *(const u32x2*)(P + zo + dv);
                const float o0 = oa[c][4 * i4 + 0] * inv * siluf_(bflo(zz.x)), o1 = oa[c][4 * i4 + 1] * inv * siluf_(bfhi(zz.x));
                const float o2 = oa[c][4 * i4 + 2] * inv * siluf_(bflo(zz.y)), o3 = oa[c][4 * i4 + 3] * inv * siluf_(bfhi(zz.y));
                u32x2 wv; wv.x = cvt_pk_bf16(o0, o1); wv.y = cvt_pk_bf16(o2, o3);
                *(u32x2*)(YA + yo + dv) = wv; }
    }
#undef AT_LOAD
#undef AT_WRITE
}

DI void phase_readout(const Params& p) {
    const bf16_t* P = (const bf16_t*)(p.ws + WS_P);
    const bf16_t* O = (const bf16_t*)(p.ws + WS_O);
    bf16_t* YB = (bf16_t*)(p.ws + WS_YB);
    const int total = NLAT * 256;
    for (int idx = blockIdx.x * NTHREADS + threadIdx.x; idx < total; idx += gridDim.x * NTHREADS) {
        const int tok = idx >> 8, col = (idx & 255) * 8;
        const u32x4 af = *(const u32x4*)(O + oix(0, tok, col >> 7, col & 127)), ab = *(const u32x4*)(O + oix(1, tok, col >> 7, col & 127));
        const f32x4 o0 = (f32x4){bflo(af.x) + bflo(ab.x), bfhi(af.x) + bfhi(ab.x), bflo(af.y) + bflo(ab.y), bfhi(af.y) + bfhi(ab.y)};
        const f32x4 o1 = (f32x4){bflo(af.z) + bflo(ab.z), bfhi(af.z) + bfhi(ab.z), bflo(af.w) + bflo(ab.w), bfhi(af.w) + bfhi(ab.w)};
        float ss = (o0[0] * o0[0] + o0[1] * o0[1]) + (o0[2] * o0[2] + o0[3] * o0[3]) + (o1[0] * o1[0] + o1[1] * o1[1]) + (o1[2] * o1[2] + o1[3] * o1[3]);
        ss += __shfl_xor(ss, 1); ss += __shfl_xor(ss, 2); ss += __shfl_xor(ss, 4); ss += __shfl_xor(ss, 8);
        const float rr = rsqrtf(ss * (1.0f / 128.0f) + 1e-6f);
        const int v0 = col & 127;
        const f32x4 n0 = *(const f32x4*)(p.hg_nw + v0), n1 = *(const f32x4*)(p.hg_nw + v0 + 4);
        const u32x4 gg = *(const u32x4*)(P + pix(tok, C_HG + col));
        u32x4 wv;
        wv.x = cvt_pk_bf16(o0[0] * rr * n0[0] * siluf_(bflo(gg.x)), o0[1] * rr * n0[1] * siluf_(bfhi(gg.x)));
        wv.y = cvt_pk_bf16(o0[2] * rr * n0[2] * siluf_(bflo(gg.y)), o0[3] * rr * n0[3] * siluf_(bfhi(gg.y)));
        wv.z = cvt_pk_bf16(o1[0] * rr * n1[0] * siluf_(bflo(gg.z)), o1[1] * rr * n1[1] * siluf_(bfhi(gg.z)));
        wv.w = cvt_pk_bf16(o1[2] * rr * n1[2] * siluf_(bflo(gg.w)), o1[3] * rr * n1[3] * siluf_(bfhi(gg.w)));
        *(u32x4*)(YB + (size_t)tok * 2048 + col) = wv;
    }
}

DI void phase_final_ln(const Params& p) {
    const int wave = threadIdx.x >> 6, lane = threadIdx.x & 63;
    for (int row = blockIdx.x * 8 + wave; row < NLAT; row += gridDim.x * 8) {
        float* src = p.out + (size_t)row * DM;
        f32x4 v[16]; float s = 0.f;
#pragma unroll
        for (int i = 0; i < 16; ++i) { v[i] = ((const f32x4*)src)[i * 64 + lane]; s += (v[i][0] + v[i][1]) + (v[i][2] + v[i][3]); }
        s = wave_sum(s); const float mean = s * (1.0f / 4096.0f);
        float q = 0.f;
#pragma unroll
        for (int i = 0; i < 16; ++i) { const f32x4 d = v[i] - mean; q += (d[0] * d[0] + d[1] * d[1]) + (d[2] * d[2] + d[3] * d[3]); }
        q = wave_sum(q); const float rstd = rsqrtf(q * (1.0f / 4096.0f) + 1e-6f);
#pragma unroll
        for (int i = 0; i < 16; ++i) { const int col = (i * 64 + lane) * 4;
            const f32x4 gg = *(const f32x4*)(p.ln_g + col), bb = *(const f32x4*)(p.ln_b + col);
            ((f32x4*)src)[i * 64 + lane] = (v[i] - mean) * rstd * gg + bb; }
    }
}

#define XB_TMO      128
#define XB_XCNT(j)  (256  + 64 * (j))
#define XB_XSUB(j)  (1280 + 64 * (j))
#define XB_XGEN(j)  (2304 + 64 * (j))
#define XB_TOP      3328
#define XB_TOPGEN   3392
#define XCD_BAR_WORDS 3456
#define XB_SPIN_CAP (1u << 18)
DI unsigned xb_ld(unsigned* p) { return __hip_atomic_load(p, __ATOMIC_RELAXED, __HIP_MEMORY_SCOPE_AGENT); }
DI unsigned xb_add(unsigned* p, unsigned v) { return __hip_atomic_fetch_add(p, v, __ATOMIC_RELAXED, __HIP_MEMORY_SCOPE_AGENT); }
DI unsigned xb_xcc_id() { return (unsigned)__builtin_amdgcn_s_getreg((3 << 11) | 20) & 0xFu; }
#define XB_SPIN(cond, bar) do { unsigned _sp = 0; while (cond) { __builtin_amdgcn_s_sleep(1); \
    if ((++_sp & 255u) == 0u) { if (xb_ld(&(bar)[XB_TMO])) break; if (_sp > XB_SPIN_CAP) { atomicAdd(&(bar)[XB_TMO], 1u); break; } } } } while (0)
struct XcdBarrier { unsigned* bar; unsigned x; volatile LAS unsigned* st; };
DI XcdBarrier xcd_barrier_post(unsigned* bar, volatile LAS unsigned* st) {
    XcdBarrier b; b.bar = bar; b.x = xb_xcc_id(); b.st = st;
    if (threadIdx.x == 0) (void)xb_add(&bar[XB_XCNT(b.x)], 1u);
    return b;
}
DI void xcd_barrier_complete(unsigned* bar, unsigned x, unsigned& nloc, unsigned& nx) {
    const unsigned G = gridDim.x * gridDim.y * gridDim.z;
    unsigned sum, cnt, mine, sp = 0u;
    for (;;) {
        sum = 0u; cnt = 0u; mine = 0u;
#pragma unroll
        for (unsigned j = 0; j < 16; ++j) { const unsigned c = xb_ld(&bar[XB_XCNT(j)]); sum += c; cnt += (c > 0u) ? 1u : 0u; mine = (j == x) ? c : mine; }
        if (sum == G) break;
        __builtin_amdgcn_s_sleep(1);
        if ((++sp & 255u) == 0u) { if (xb_ld(&bar[XB_TMO])) break; if (sp > XB_SPIN_CAP) { atomicAdd(&bar[XB_TMO], 1u); break; } }
    }
    nloc = mine > 0u ? mine : 1u; nx = cnt > 0u ? cnt : 1u;
}
DI void xcd_barrier(const XcdBarrier& b) {
    asm volatile("s_waitcnt vmcnt(0)" ::: "memory");
    __syncthreads();
    if (threadIdx.x == 0) {
        unsigned* bar = b.bar;
        __builtin_amdgcn_s_waitcnt(0);
        unsigned nloc = b.st[0], nx = b.st[1];
        if (nloc == 0u) { xcd_barrier_complete(bar, b.x, nloc, nx); b.st[0] = nloc; b.st[1] = nx; }
        const unsigned old = xb_add(&bar[XB_XSUB(b.x)], 1u);
        const unsigned gen = old / nloc;
        if (old + 1u == (gen + 1u) * nloc) {
            __builtin_amdgcn_fence(__ATOMIC_RELEASE, "agent");
            asm volatile("s_waitcnt vmcnt(0)" ::: "memory");
            const unsigned og = xb_add(&bar[XB_TOP], 1u);
            const unsigned tg = og / nx;
            if (og + 1u == (tg + 1u) * nx) xb_add(&bar[XB_TOPGEN], 1u);
            else XB_SPIN(xb_ld(&bar[XB_TOPGEN]) == tg, bar);
            __builtin_amdgcn_fence(__ATOMIC_ACQUIRE, "agent");
            xb_add(&bar[XB_XGEN(b.x)], 1u);
            asm volatile("s_waitcnt vmcnt(0)" ::: "memory");
        } else {
            XB_SPIN(xb_ld(&bar[XB_XGEN(b.x)]) == gen, bar);
            __builtin_amdgcn_fence(__ATOMIC_ACQUIRE, "agent");
            asm volatile("s_waitcnt vmcnt(0)" ::: "memory");
        }
    }
    __syncthreads();
}

__global__ void __launch_bounds__(NTHREADS, 2) fwd_megakernel(Params p) {
    extern __shared__ __attribute__((aligned(16))) unsigned char lds[];
    cg::grid_group grid = cg::this_grid();
    const int lo = p.ph_lo, hi = p.ph_hi;
    if (lo < 0) grid.sync();
    volatile LAS unsigned* bst = (volatile LAS unsigned*)((LAS unsigned char*)lds + (LDS_BYTES - 16));
    if (threadIdx.x < 4) bst[threadIdx.x] = 0u;
    __syncthreads();
    XcdBarrier xbar = xcd_barrier_post((unsigned*)(p.ws + WS_BAR), bst);
#define IN(k) (lo <= (k) && (k) < hi)
#define SEAM(k) do { if (IN(k) && IN((k) + 1)) xcd_barrier(xbar); } while (0)
    float* mod = (float*)(p.ws + WS_MOD);
    const bool fuse_ln = (gridDim.x == 256) && IN(6) && IN(7);
    bf16_t* H = (bf16_t*)(p.ws + WS_H);
    bf16_t* Pb = (bf16_t*)(p.ws + WS_P);
    if (IN(0)) { phase_adaln(p, mod, lds); phase_weights(p, lds); }
    SEAM(0);
    if (IN(1)) phase_ln_mod(p, mod, H);
    SEAM(1);
    if (IN(2)) {
        const bf16_t* WinT = (const bf16_t*)(p.ws + WS_WIN);
        pg8::Gemm g{H, WinT, nullptr, nullptr, NLAT, NIN, DM, DM};
        pg8::StaticOrder<1> S; S.init(NLAT, NIN, gridDim.x, blockIdx.x);
        EpiP E{Pb};
        pg8::gemm_phase<EpiP, pg8::StaticOrder<1>>((LAS unsigned char*)lds, g, S, E);
        float* SC = (float*)(p.ws + WS_M);
        pg8::Gemm gc{H, WinT, H + 2048, WinT + 2048, MROWS, NIN, 2048, DM};
        CtxOrder Sx{(int)blockIdx.x, (int)gridDim.x};
        EpiCtx Ec{SC};
        pg8::gemm_phase<EpiCtx, CtxOrder>((LAS unsigned char*)lds, gc, Sx, Ec);
        xcd_barrier(xbar);
        ctx_combine(p, SC, Pb);
    }
    SEAM(2);
    if (IN(3)) {
        hgrn_h1(p, lds);
        xcd_barrier(xbar);
        const int cx = ((gridDim.x & 7) == 0) ? (int)((blockIdx.x & 7) * (gridDim.x >> 3) + (blockIdx.x >> 3)) : (int)blockIdx.x;
        for (int it = cx; it < 256; it += gridDim.x) hgrn_h2(p, it, lds);
        for (int it = cx; it < 1024; it += gridDim.x) attn_item(p, it, lds);
    }
    SEAM(3);
    if (IN(4)) phase_readout(p);
    SEAM(4);
    if (IN(5)) {
        pg8::Gemm g{(const bf16_t*)(p.ws + WS_YA), (const bf16_t*)(p.ws + WS_WPA), (const bf16_t*)(p.ws + WS_YB), (const bf16_t*)(p.ws + WS_WPB), NLAT, DM, 2048, 2048};
        pg8::StaticOrder<2> S; S.init(NLAT, DM, gridDim.x, blockIdx.x);
        EpiM E{Pb, (bf16_t*)(p.ws + WS_M)};
        pg8::gemm_phase<EpiM, pg8::StaticOrder<2>>((LAS unsigned char*)lds, g, S, E);
    }
    SEAM(5);
    if (IN(6)) {
        pg8::Gemm g{(const bf16_t*)(p.ws + WS_M), (const bf16_t*)(p.ws + WS_WOUT), nullptr, nullptr, NLAT, DM, DM, DM};
        if (fuse_ln) {
            RowBlockOrder S; S.init(blockIdx.x);
            EpiLnOut E{p.x, mod, p.ln_g, p.ln_b, p.out, (unsigned long long*)(p.ws + WS_SLOT), (unsigned*)(p.ws + WS_CNT), (LAS unsigned char*)lds + 131072};
            pg8::gemm_phase<EpiLnOut, RowBlockOrder>((LAS unsigned char*)lds, g, S, E);
        } else {
            pg8::StaticOrder<1> S; S.init(NLAT, DM, gridDim.x, blockIdx.x);
            EpiOut E{p.x, mod, p.out};
            pg8::gemm_phase<EpiOut, pg8::StaticOrder<1>>((LAS unsigned char*)lds, g, S, E);
        }
    }
    if (!fuse_ln) { SEAM(6); if (IN(7)) phase_final_ln(p); }
#undef IN
#undef SEAM
}

extern "C" void kernel_launch(void* const* d_in, const int* in_sizes, int n_in, void* d_out, int out_size, void* d_ws, size_t ws_size, hipStream_t stream) {
    static int grid = 0;
    if (grid == 0) {
        if (n_in != 16 || ws_size < WS_END) { fprintf(stderr, "kernel_launch: bad n_in %d or ws_size %zu < %zu\n", n_in, ws_size, (size_t)WS_END); grid = -1; return; }
        int dev = 0, cus = 0, per_cu = 0;
        hipGetDevice(&dev);
        hipDeviceGetAttribute(&cus, hipDeviceAttributeMultiprocessorCount, dev);
        if (hipFuncSetAttribute((const void*)fwd_megakernel, hipFuncAttributeMaxDynamicSharedMemorySize, LDS_BYTES) != hipSuccess) { fprintf(stderr, "kernel_launch: hipFuncSetAttribute failed\n"); grid = -1; return; }
        hipOccupancyMaxActiveBlocksPerMultiprocessor(&per_cu, (const void*)fwd_megakernel, NTHREADS, LDS_BYTES);
        if (per_cu < 1) { fprintf(stderr, "kernel_launch: occupancy query says %d blocks/CU\n", per_cu); per_cu = 1; }
        (void)hipGetLastError();
        grid = cus;
    }
    if (grid < 0) return;
    Params p{};
    p.x = (const float*)d_in[0]; p.c = (const float*)d_in[1]; p.ctx = (const float*)d_in[2]; p.c_ctx = (const float*)d_in[3];
    p.w_ada = (const float*)d_in[4]; p.b_ada = (const float*)d_in[5]; p.w_in = (const float*)d_in[6]; p.rpb = (const float*)d_in[7];
    p.lb_fwd = (const float*)d_in[8]; p.lb_bwd = (const float*)d_in[9]; p.hg_nw = (const float*)d_in[10]; p.w_pa = (const float*)d_in[11];
    p.w_pb = (const float*)d_in[12]; p.w_out = (const float*)d_in[13]; p.ln_g = (const float*)d_in[14]; p.ln_b = (const float*)d_in[15];
    p.out = (float*)d_out; p.ws = (unsigned char*)d_ws; p.ph_lo = 0; p.ph_hi = 8;
    void* args[] = {&p};
    if (hipMemsetAsync((char*)d_ws + WS_BAR, 0, ZERO_BYTES, stream) != hipSuccess) { fprintf(stderr, "kernel_launch: memset of barrier words failed\n"); return; }
    hipError_t e = hipLaunchCooperativeKernel((const void*)fwd_megakernel, dim3(grid), dim3(NTHREADS), args, LDS_BYTES, stream);
    if (e != hipSuccess) fprintf(stderr, "cooperative launch failed: %s (grid %d)\n", hipGetErrorString(e), grid);
}
```

```cpp
#include <hip/hip_runtime.h>
#include <hip/hip_cooperative_groups.h>
#include <cstdio>
namespace cg = cooperative_groups;

#define DI __device__ __forceinline__
#define LAS __attribute__((address_space(3)))
typedef unsigned short bf16_t;
typedef short bf16x8 __attribute__((ext_vector_type(8)));
typedef short s16x4 __attribute__((ext_vector_type(4)));
typedef float f32x4 __attribute__((ext_vector_type(4)));
typedef unsigned u32x4 __attribute__((ext_vector_type(4)));
typedef unsigned u32x2 __attribute__((ext_vector_type(2)));

constexpr int DM = 4096, NB = 2, TT = 8192, LC = 256;
constexpr int NLAT = NB * TT;
constexpr int MROWS = NLAT + NB * LC;
constexpr int NIN = 26624;
constexpr int C_Q = 0, C_K = 2048, C_V = 4096, C_Z = 6144, C_HQ = 8192, C_FF = 10240, C_FB = 12288, C_HI = 14336, C_HG = 16384, C_GA = 18432, C_GB = 22528;
constexpr float ALPHA_F = 1.189207115002721f;
constexpr int NTHREADS = 512;
constexpr int LDS_BYTES = 131072 + 8192 + 256;

constexpr size_t WS_WIN = 0;
constexpr size_t WS_H = WS_WIN + (size_t)NIN * DM * 2;
constexpr size_t WS_O = 0;
constexpr size_t WS_P = WS_H + (size_t)MROWS * DM * 2;
constexpr size_t WS_WPA = WS_P + (size_t)MROWS * NIN * 2;
constexpr size_t WS_WPB = WS_WPA + (size_t)DM * 2048 * 2;
constexpr size_t WS_WOUT = WS_WPB + (size_t)DM * 2048 * 2;
constexpr size_t WS_YA = WS_WOUT + (size_t)DM * DM * 2;
constexpr size_t WS_YB = WS_YA + (size_t)NLAT * 2048 * 2;
constexpr size_t WS_M = WS_YB + (size_t)NLAT * 2048 * 2;
constexpr size_t WS_MOD = WS_M + (size_t)NLAT * DM * 2;
constexpr size_t WS_BAR = WS_MOD + 3 * 12288 * 4;
constexpr size_t WS_CNT = WS_BAR + 3456 * 4;
constexpr size_t WS_SLOT = WS_CNT + 64 * 64 * 4;
constexpr size_t WS_END = WS_SLOT + (size_t)NLAT * 16 * 8;
constexpr size_t ZERO_BYTES = WS_SLOT - WS_BAR;
static_assert((size_t)2 * NLAT * 2048 * 4 <= WS_P, "O alias must fit before P");

struct Params {
    const float* x; const float* c; const float* ctx; const float* c_ctx; const float* w_ada; const float* b_ada; const float* w_in;
    const float* rpb; const float* lb_fwd; const float* lb_bwd; const float* hg_nw; const float* w_pa; const float* w_pb; const float* w_out;
    const float* ln_g; const float* ln_b;
    float* out; unsigned char* ws;
    int ph_lo, ph_hi;
};

DI size_t oix(int dir, int tok, int h, int v) { return (((size_t)(dir * 16 + h)) * NLAT + (size_t)tok) * 128 + (size_t)v; }
DI size_t pix(int row, int col) { return ((size_t)(col >> 8) * MROWS + (size_t)row) * 256 + (size_t)(col & 255); }
DI bf16_t f2bf(float f) { unsigned u = __float_as_uint(f); u += 0x7FFFu + ((u >> 16) & 1u); return (bf16_t)(u >> 16); }
DI float bf2f(unsigned b) { return __uint_as_float(b << 16); }
DI float bflo(unsigned w) { return __uint_as_float(w << 16); }
DI float bfhi(unsigned w) { return __uint_as_float(w & 0xffff0000u); }
DI unsigned cvt_pk_bf16(float lo, float hi) { unsigned r; asm volatile("v_cvt_pk_bf16_f32 %0, %1, %2" : "=v"(r) : "v"(lo), "v"(hi)); return r; }
DI float wave_sum(float v) { v += __shfl_xor(v, 32); v += __shfl_xor(v, 16); v += __shfl_xor(v, 8); v += __shfl_xor(v, 4); v += __shfl_xor(v, 2); v += __shfl_xor(v, 1); return v; }
DI float sigmoidf_(float v) { return __builtin_amdgcn_rcpf(1.0f + __expf(-v)); }
DI float siluf_(float v) { return v * __builtin_amdgcn_rcpf(1.0f + __expf(-v)); }
#define MFMA16(a, b, c) __builtin_amdgcn_mfma_f32_16x16x32_bf16((a), (b), (c), 0, 0, 0)

namespace pg8 {
constexpr int BM = 256, BK = 64, HALF = 128, HTB = HALF * BK * 2, STAGE_BYTES = 8 * HTB, NXCD = 8, WGM = 8;
DI int lds_byte(int r, int c) { const int st = (r >> 4) * 2 + (c >> 5), rr = r & 15, cc = c & 31, ob = rr * 64 + cc * 2; return st * 1024 + (ob ^ (((ob >> 9) & 1) << 5)); }
DI void stage_rc(int b, int& R, int& C) { const int st = b / 1024, sb = b % 1024, swz = sb ^ (((sb >> 9) & 1) << 5); R = (st >> 1) * 16 + swz / 64; C = (st & 1) * 32 + (swz % 64) / 2; }
DI int perm32(int rho) { const int n = rho >> 4, i = rho & 15; return 8 * (i >> 2) + 4 * n + (i & 3); }

struct Unit { int pm, pn, z; };
struct Gemm { const bf16_t* A; const bf16_t* Bt; const bf16_t* A2; const bf16_t* Bt2; int M, N, K, ld; };

template <int ZN> struct StaticOrder {
    int nM, nN, nwg, G, c;
    DI void init(int M, int N, int G_, int c_) { nM = M / BM; nN = N / BM; nwg = nM * nN; G = G_; c = c_; }
    DI bool next(int i, Unit& u) const {
        const int it = (ZN == 2) ? (i >> 1) : i;
        const long L = (long)it * G + c; if (L >= nwg) return false;
        int wgid = (int)L; { const int q = nwg / NXCD, r = nwg % NXCD, xcd = wgid % NXCD, off = wgid / NXCD; wgid = (xcd < r ? xcd * (q + 1) : r * (q + 1) + (xcd - r) * q) + off; }
        const int nig = WGM * nN, gid = wgid / nig, fm = gid * WGM, gsz = (nM - fm) < WGM ? (nM - fm) : WGM;
        u.pm = fm + ((wgid % nig) % gsz); u.pn = (wgid % nig) / gsz; u.z = (ZN == 2) ? (i & 1) : 0; return true;
    }
};

template <class Epi, class Sched>
DI void gemm_phase(LAS unsigned char* lds, const Gemm g, const Sched& S, const Epi& E) {
    const int tid = threadIdx.x, wid = __builtin_amdgcn_readfirstlane(tid >> 6), lane = tid & 63, wr = wid >> 2, wc = wid & 3, fr = lane & 15, fq = lane >> 4;
    const int K = g.K, nt = K / BK, LD = g.ld;
    unsigned voffA[2], voffB[2];
#pragma unroll
    for (int i = 0; i < 2; ++i) { int R, C; stage_rc(tid * 16 + i * 8192, R, C); const int Rb = Epi::PERM ? ((R & ~31) + perm32(R & 31)) : R;
        voffA[i] = (unsigned)(R * LD + C) * 2u; voffB[i] = (unsigned)(Rb * LD + C) * 2u; }
    const size_t kstep = (size_t)(BK * 2);
    const size_t hstep = (size_t)HALF * LD * 2;
    const size_t tstep = 2 * hstep;
    const unsigned ldsw = (unsigned)wid * 1024u;
    const int aoff = lds_byte(wr * 64 + fr, fq * 8), boff = lds_byte(wc * 32 + fr, fq * 8);
#define PG8_SA(b, h) (((b) * 2 + (h)) * HTB)
#define PG8_SB(b, h) ((4 + (b) * 2 + (h)) * HTB)
#define PG8_STAGE(bufoff, gbase, voff) do { _Pragma("unroll") for (int _i = 0; _i < 2; ++_i) \
        __builtin_amdgcn_global_load_lds((const unsigned*)((const char*)(gbase) + (voff)[_i]), (LAS unsigned*)(lds + (bufoff) + ldsw + _i * 8192), 16, 0, 0); } while (0)
#define PG8_LDA(dst, b, h) do { _Pragma("unroll") for (int m = 0; m < 4; ++m) _Pragma("unroll") for (int k = 0; k < 2; ++k) dst[m][k] = *(const LAS bf16x8*)(lds + PG8_SA(b, h) + aoff + m * 2048 + k * 1024); } while (0)
#define PG8_LDB(dst, b, h) do { _Pragma("unroll") for (int n = 0; n < 2; ++n) _Pragma("unroll") for (int k = 0; k < 2; ++k) dst[n][k] = *(const LAS bf16x8*)(lds + PG8_SB(b, h) + boff + n * 2048 + k * 1024); } while (0)
#define PG8_MMA(ai, bj, At, Bt) do { __builtin_amdgcn_s_setprio(1); _Pragma("unroll") for (int m = 0; m < 4; ++m) _Pragma("unroll") for (int n = 0; n < 2; ++n) _Pragma("unroll") for (int k = 0; k < 2; ++k) \
        acc[ai][bj][m][n] = __builtin_amdgcn_mfma_f32_16x16x32_bf16(Bt[n][k], At[m][k], acc[ai][bj][m][n], 0, 0, 0); __builtin_amdgcn_s_setprio(0); } while (0)
#define PG8_WAIT_V(n) asm volatile("s_waitcnt vmcnt(" #n ")" ::: "memory")
#define PG8_WAIT_L(n) asm volatile("s_waitcnt lgkmcnt(" #n ")" ::: "memory")
#define PG8_BAR __builtin_amdgcn_s_barrier()
#define PG8_SCHED __builtin_amdgcn_sched_barrier(0)
#define PG8_ABASE(u) ((const char*)((u).z ? g.A2 : g.A) + (size_t)(u).pm * tstep)
#define PG8_BBASE(u) ((const char*)((u).z ? g.Bt2 : g.Bt) + (size_t)(u).pn * tstep)
    Unit cur, nxt; int ui = 0;
    if (!S.next(0, cur)) return;
    f32x4 acc[2][2][4][2];
#pragma unroll
    for (int a = 0; a < 2; ++a)
#pragma unroll
        for (int b = 0; b < 2; ++b)
#pragma unroll
            for (int m = 0; m < 4; ++m)
#pragma unroll
                for (int n = 0; n < 2; ++n) acc[a][b][m][n] = (f32x4){0.f, 0.f, 0.f, 0.f};
    bf16x8 At[4][2], B0[2][2], B1[2][2];
    const char* cA = PG8_ABASE(cur); const char* cB = PG8_BBASE(cur);
    PG8_STAGE(PG8_SB(0, 0), cB, voffB); PG8_STAGE(PG8_SA(0, 0), cA, voffA); PG8_STAGE(PG8_SB(0, 1), cB + hstep, voffB); PG8_STAGE(PG8_SA(0, 1), cA + hstep, voffA);
    if (wr == 1) PG8_BAR;
    PG8_WAIT_V(4); PG8_BAR;
    PG8_STAGE(PG8_SB(1, 0), cB + kstep, voffB); PG8_STAGE(PG8_SA(1, 0), cA + kstep, voffA); PG8_STAGE(PG8_SB(1, 1), cB + hstep + kstep, voffB);
    PG8_WAIT_V(6); PG8_BAR;
    for (;;) {
        const bool has_next = S.next(ui + 1, nxt);
        const char* nA = has_next ? PG8_ABASE(nxt) : cA; const char* nB = has_next ? PG8_BBASE(nxt) : cB;
        for (int t = 0; t < nt; t += 2) {
            const bool last = (t == nt - 2);
            const char* a1 = cA + (size_t)(t + 1) * kstep;
            const char* a2 = last ? nA : cA + (size_t)(t + 2) * kstep; const char* b2 = last ? nB : cB + (size_t)(t + 2) * kstep;
            const char* a3 = a2 + kstep; const char* b3 = b2 + kstep;
            PG8_LDB(B0, 0, 0); PG8_SCHED; PG8_LDA(At, 0, 0); PG8_STAGE(PG8_SA(1, 1), a1 + hstep, voffA);
            PG8_WAIT_L(8); PG8_BAR; PG8_WAIT_L(0); PG8_MMA(0, 0, At, B0); PG8_BAR; PG8_SCHED;
            PG8_LDB(B1, 0, 1); PG8_STAGE(PG8_SB(0, 0), b2, voffB);
            PG8_BAR; PG8_WAIT_L(0); PG8_MMA(0, 1, At, B1); PG8_BAR;
            PG8_LDA(At, 0, 1); PG8_STAGE(PG8_SA(0, 0), a2, voffA);
            PG8_BAR; PG8_WAIT_L(0); PG8_MMA(1, 0, At, B0); PG8_BAR; PG8_SCHED;
            PG8_STAGE(PG8_SB(0, 1), b2 + hstep, voffB);
            PG8_WAIT_V(6); PG8_BAR; PG8_MMA(1, 1, At, B1); PG8_BAR;
            PG8_LDB(B0, 1, 0); PG8_SCHED; PG8_LDA(At, 1, 0); PG8_STAGE(PG8_SA(0, 1), a2 + hstep, voffA);
            PG8_WAIT_L(8); PG8_BAR; PG8_WAIT_L(0); PG8_MMA(0, 0, At, B0); PG8_BAR; PG8_SCHED;
            PG8_LDB(B1, 1, 1); PG8_STAGE(PG8_SB(1, 0), b3, voffB);
            PG8_BAR; PG8_WAIT_L(0); PG8_MMA(0, 1, At, B1); PG8_BAR;
            PG8_LDA(At, 1, 1); PG8_STAGE(PG8_SA(1, 0), a3, voffA);
            PG8_BAR; PG8_WAIT_L(0); PG8_MMA(1, 0, At, B0); PG8_BAR; PG8_SCHED;
            PG8_STAGE(PG8_SB(1, 1), b3 + hstep, voffB);
            PG8_WAIT_V(6); PG8_BAR; PG8_MMA(1, 1, At, B1); PG8_BAR;
        }
        const bool keep = E(acc, cur, wr, wc, fr, fq);
        if (!has_next) break;
        if (!keep) {
#pragma unroll
        for (int a = 0; a < 2; ++a)
#pragma unroll
            for (int b = 0; b < 2; ++b)
#pragma unroll
                for (int m = 0; m < 4; ++m)
#pragma unroll
                    for (int n = 0; n < 2; ++n) acc[a][b][m][n] = (f32x4){0.f, 0.f, 0.f, 0.f};
        }
        cur = nxt; cA = nA; cB = nB; ++ui;
    }
    PG8_WAIT_V(0);
    if (wr == 0) PG8_BAR;
    PG8_BAR;
#undef PG8_SA
#undef PG8_SB
#undef PG8_STAGE
#undef PG8_LDA
#undef PG8_LDB
#undef PG8_MMA
#undef PG8_WAIT_V
#undef PG8_WAIT_L
#undef PG8_BAR
#undef PG8_SCHED
#undef PG8_ABASE
#undef PG8_BBASE
}
}

struct EpiP {
    static constexpr bool PERM = true;
    bf16_t* O;
    DI bool operator()(const f32x4 (&acc)[2][2][4][2], const pg8::Unit& u, int wr, int wc, int fr, int fq) const {
        const int row0 = u.pm * 256 + wr * 64 + fr, col0 = u.pn * 256 + wc * 32 + 8 * fq;
        const bool hq = (u.pn >= C_HQ / 256) && (u.pn < C_FF / 256);
#pragma unroll
        for (int ai = 0; ai < 2; ++ai)
#pragma unroll
            for (int m = 0; m < 4; ++m) { bf16_t* rowp = O + pix(row0 + ai * 128 + m * 16, col0);
#pragma unroll
                for (int bj = 0; bj < 2; ++bj) { f32x4 v0 = acc[ai][bj][m][0], v1 = acc[ai][bj][m][1];
                    if (hq) {
#pragma unroll
                        for (int e = 0; e < 4; ++e) { v0[e] = siluf_(v0[e]); v1[e] = siluf_(v1[e]); } }
                    u32x4 w; w.x = cvt_pk_bf16(v0[0], v0[1]); w.y = cvt_pk_bf16(v0[2], v0[3]); w.z = cvt_pk_bf16(v1[0], v1[1]); w.w = cvt_pk_bf16(v1[2], v1[3]);
                    *(u32x4*)(rowp + bj * 128) = w; } }
        return false;
    }
};
DI int ctx_pn(int j) { return j < 8 ? 8 + j : (j < 16 ? 8 + j : 24 + j); }
struct CtxOrder {
    int c, G;
    DI bool next(int i, pg8::Unit& u) const { const int id = c + i * G; if (id >= 160) return false; const int t = id >> 1; u.pm = 64 + t / 40; u.pn = ctx_pn(t % 40); u.z = id & 1; return true; }
};
struct EpiCtx {
    static constexpr bool PERM = false;
    float* SC;
    DI bool operator()(const f32x4 (&acc)[2][2][4][2], const pg8::Unit& u, int wr, int wc, int fr, int fq) const {
        const int pnj = u.pn < 24 ? u.pn - 8 : u.pn - 24;
        float* base = SC + ((size_t)(u.z * 80 + (u.pm - 64) * 40 + pnj)) * 65536 + (size_t)(wr * 64 + fr) * 256 + wc * 32 + 4 * fq;
#pragma unroll
        for (int ai = 0; ai < 2; ++ai)
#pragma unroll
            for (int m = 0; m < 4; ++m)
#pragma unroll
                for (int bj = 0; bj < 2; ++bj)
#pragma unroll
                    for (int n = 0; n < 2; ++n) *(f32x4*)(base + (size_t)(ai * 128 + m * 16) * 256 + bj * 128 + n * 16) = acc[ai][bj][m][n];
        return false;
    }
};
DI void ctx_combine(const Params& p, const float* SC, bf16_t* P) {
    const int total = 80 * 8192;
    for (int e = blockIdx.x * NTHREADS + threadIdx.x; e < total; e += gridDim.x * NTHREADS) {
        const int t = e >> 13, w8 = (e & 8191) * 8, row = w8 >> 8, col = w8 & 255;
        const float* a = SC + (size_t)t * 65536 + w8; const float* b = a + (size_t)80 * 65536;
        const f32x4 a0 = *(const f32x4*)a, a1 = *(const f32x4*)(a + 4), b0 = *(const f32x4*)b, b1 = *(const f32x4*)(b + 4);
        const f32x4 s0 = a0 + b0, s1 = a1 + b1;
        u32x4 w; w.x = cvt_pk_bf16(s0[0], s0[1]); w.y = cvt_pk_bf16(s0[2], s0[3]); w.z = cvt_pk_bf16(s1[0], s1[1]); w.w = cvt_pk_bf16(s1[2], s1[3]);
        *(u32x4*)(P + pix((64 + t / 40) * 256 + row, ctx_pn(t % 40) * 256 + col)) = w;
    }
}
struct EpiM {
    static constexpr bool PERM = true;
    const bf16_t* P; bf16_t* Mo;
    DI bool operator()(f32x4 (&acc)[2][2][4][2], const pg8::Unit& u, int wr, int wc, int fr, int fq) const {
        const int row0 = u.pm * 256 + wr * 64 + fr, col0 = u.pn * 256 + wc * 32 + 8 * fq;
        const bool z0 = (u.z == 0);
#pragma unroll
        for (int ai = 0; ai < 2; ++ai) {
            u32x4 gbv[4][2], gav[4][2];
#pragma unroll
            for (int m = 0; m < 4; ++m) { const int row = row0 + ai * 128 + m * 16;
                const bf16_t* pgb = P + pix(row, C_GB + col0); const bf16_t* pga = P + pix(row, C_GA + col0);
#pragma unroll
                for (int bj = 0; bj < 2; ++bj) { gbv[m][bj] = *(const u32x4*)(pgb + bj * 128); if (z0) gav[m][bj] = *(const u32x4*)(pga + bj * 128); else gav[m][bj] = gbv[m][bj]; } }
            __builtin_amdgcn_sched_barrier(0);
#pragma unroll
            for (int m = 0; m < 4; ++m) { const int row = row0 + ai * 128 + m * 16;
#pragma unroll
                for (int bj = 0; bj < 2; ++bj) {
                    const u32x4 gb = gbv[m][bj];
                    if (z0) {
                        const u32x4 ga = gav[m][bj];
#pragma unroll
                        for (int e = 0; e < 4; ++e) {
                            const float a0 = bflo(ga[e]), a1 = bfhi(ga[e]), b0 = bflo(gb[e]), b1 = bfhi(gb[e]);
                            const float r0 = (1.0f + __expf(-b0)) * __builtin_amdgcn_rcpf(1.0f + __expf(-a0)), r1 = (1.0f + __expf(-b1)) * __builtin_amdgcn_rcpf(1.0f + __expf(-a1));
                            acc[ai][bj][m][e >> 1][(e & 1) * 2] *= r0; acc[ai][bj][m][e >> 1][(e & 1) * 2 + 1] *= r1; }
                    } else {
                        u32x4 w;
#pragma unroll
                        for (int e = 0; e < 4; ++e) {
                            const float s0 = sigmoidf_(bflo(gb[e])), s1 = sigmoidf_(bfhi(gb[e]));
                            w[e] = cvt_pk_bf16(acc[ai][bj][m][e >> 1][(e & 1) * 2] * s0, acc[ai][bj][m][e >> 1][(e & 1) * 2 + 1] * s1); }
                        *(u32x4*)(Mo + (size_t)row * DM + col0 + bj * 128) = w;
                    } } }
            __builtin_amdgcn_sched_barrier(0);
        }
        return z0;
    }
};
struct EpiOut {
    static constexpr bool PERM = false;
    const float* x; const float* mod; float* out;
    DI bool operator()(const f32x4 (&acc)[2][2][4][2], const pg8::Unit& u, int wr, int wc, int fr, int fq) const {
        const int row0 = u.pm * 256 + wr * 64 + fr, col0 = u.pn * 256 + wc * 32 + 4 * fq;
        const float* gate = mod + (size_t)(u.pm >> 5) * 12288 + 8192;
        f32x4 gv[2][2];
#pragma unroll
        for (int bj = 0; bj < 2; ++bj)
#pragma unroll
            for (int n = 0; n < 2; ++n) gv[bj][n] = *(const f32x4*)(gate + col0 + bj * 128 + n * 16);
#pragma unroll
        for (int ai = 0; ai < 2; ++ai)
#pragma unroll
            for (int m = 0; m < 4; ++m) { const size_t off = (size_t)(row0 + ai * 128 + m * 16) * DM + col0;
#pragma unroll
                for (int bj = 0; bj < 2; ++bj)
#pragma unroll
                    for (int n = 0; n < 2; ++n) { const f32x4 xv = *(const f32x4*)(x + off + bj * 128 + n * 16);
                        *(f32x4*)(out + off + bj * 128 + n * 16) = xv * ALPHA_F + gv[bj][n] * acc[ai][bj][m][n]; } }
        return false;
    }
};

struct RowBlockOrder {
    int x, s;
    DI void init(int c) { x = c & 7; s = c >> 3; }
    DI bool next(int i, pg8::Unit& u) const { if (i >= 4) return false; u.z = 0; u.pm = 16 * i + 8 * (x & 1) + (s & 7); u.pn = 4 * (x >> 1) + (s >> 3); return true; }
};
struct EpiLnOut {
    static constexpr bool PERM = false;
    const float* x; const float* mod; const float* ln_g; const float* ln_b; float* out;
    unsigned long long* slots; unsigned* cnt; LAS unsigned char* ptab;
    DI bool operator()(f32x4 (&acc)[2][2][4][2], const pg8::Unit& u, int wr, int wc, int fr, int fq) const {
        typedef float f32x2v __attribute__((ext_vector_type(2)));
        int t_ = threadIdx.x; asm volatile("" : "+v"(t_));
        wr = t_ >> 8; wc = (t_ >> 6) & 3; fr = t_ & 15; fq = (t_ >> 4) & 3;
        const int pm = __builtin_amdgcn_readfirstlane(u.pm), pn = __builtin_amdgcn_readfirstlane(u.pn);
        const unsigned loff = (unsigned)(((wr * 64 + fr) * DM + wc * 32 + 4 * fq) * 4);
        const unsigned coff = (unsigned)((wc * 32 + 4 * fq) * 4);
        const char* xt = (const char*)(x + (size_t)pm * 256 * DM + pn * 256);
        char* ot = (char*)(out + (size_t)pm * 256 * DM + pn * 256);
        const char* gt = (const char*)(mod + (size_t)(pm >> 5) * 12288 + 8192 + pn * 256);
        {
            f32x4 gv[2][2];
#pragma unroll
            for (int bj = 0; bj < 2; ++bj)
#pragma unroll
                for (int n = 0; n < 2; ++n) gv[bj][n] = *(const f32x4*)(gt + coff + (bj * 128 + n * 16) * 4);
#pragma unroll
            for (int ai = 0; ai < 2; ++ai)
#pragma unroll
                for (int m = 0; m < 4; ++m) { const char* xr = xt + (size_t)(ai * 128 + m * 16) * DM * 4;
#pragma unroll
                    for (int bj = 0; bj < 2; ++bj)
#pragma unroll
                        for (int n = 0; n < 2; ++n) { const f32x4 xv = *(const f32x4*)(xr + loff + (bj * 128 + n * 16) * 4); acc[ai][bj][m][n] = xv * ALPHA_F + gv[bj][n] * acc[ai][bj][m][n]; }
                    asm volatile("" : "+v"(acc[ai][0][m][0]), "+v"(acc[ai][0][m][1]), "+v"(acc[ai][1][m][0]), "+v"(acc[ai][1][m][1]) :: "memory"); }
        }
        LAS f32x2v* Pt = (LAS f32x2v*)ptab;
#pragma unroll
        for (int ai = 0; ai < 2; ++ai)
#pragma unroll
            for (int m = 0; m < 4; ++m) { float s1 = 0.f, s2 = 0.f;
#pragma unroll
                for (int bj = 0; bj < 2; ++bj)
#pragma unroll
                    for (int n = 0; n < 2; ++n) { const f32x4 v = acc[ai][bj][m][n]; s1 += (v[0] + v[1]) + (v[2] + v[3]); s2 += (v[0] * v[0] + v[1] * v[1]) + (v[2] * v[2] + v[3] * v[3]); }
                s1 += __shfl_xor(s1, 16); s1 += __shfl_xor(s1, 32); s2 += __shfl_xor(s2, 16); s2 += __shfl_xor(s2, 32);
                if (fq == 0) Pt[(ai * 128 + wr * 64 + m * 16 + fr) * 4 + wc] = (f32x2v){s1, s2}; }
        asm volatile("s_waitcnt lgkmcnt(0)" ::: "memory"); __builtin_amdgcn_s_barrier(); asm volatile("" ::: "memory");
        unsigned long long* st = slots + (size_t)pm * 256 * 16;
        const int hl = t_ & 255;
        if (hl < 128) { const int rl = (hl >> 6) * 128 + wr * 64 + (hl & 63);
            const f32x2v a = Pt[rl * 4 + 0], b = Pt[rl * 4 + 1], c = Pt[rl * 4 + 2], d = Pt[rl * 4 + 3];
            const float S1 = (a.x + b.x) + (c.x + d.x), S2 = (a.y + b.y) + (c.y + d.y);
            __hip_atomic_store(st + (rl * 16 + pn), ((unsigned long long)__float_as_uint(S2) << 32) | __float_as_uint(S1), __ATOMIC_RELAXED, __HIP_MEMORY_SCOPE_AGENT); }
        asm volatile("s_waitcnt vmcnt(0)" ::: "memory");
        unsigned* mycnt = cnt + 64 * pm + 32 * wr;
        if ((t_ & 63) == 0) __hip_atomic_fetch_add(mycnt, 1u, __ATOMIC_RELAXED, __HIP_MEMORY_SCOPE_AGENT);
        { unsigned sp = 0;
          while ((unsigned)__builtin_amdgcn_readfirstlane(__hip_atomic_load(mycnt, __ATOMIC_RELAXED, __HIP_MEMORY_SCOPE_AGENT)) < 64u) { __builtin_amdgcn_s_sleep(2); if (++sp > (1u << 17)) break; } }
        __builtin_amdgcn_fence(__ATOMIC_ACQUIRE, "agent");
        asm volatile("s_waitcnt vmcnt(0)" ::: "memory");
        const unsigned soff = (unsigned)(((wr * 64 + fr) * 16 + fq * 4) * 8);
        const char* lgt = (const char*)(ln_g + pn * 256); const char* lbt = (const char*)(ln_b + pn * 256);
#pragma unroll
        for (int ai = 0; ai < 2; ++ai)
#pragma unroll
            for (int m = 0; m < 4; ++m) {
                const char* sr = (const char*)st + (size_t)(ai * 128 + m * 16) * 16 * 8;
                float t1 = 0.f, t2 = 0.f;
#pragma unroll
                for (int t = 0; t < 4; ++t) { const unsigned long long w = __hip_atomic_load((const unsigned long long*)(sr + soff + t * 8), __ATOMIC_RELAXED, __HIP_MEMORY_SCOPE_AGENT); t1 += __uint_as_float((unsigned)w); t2 += __uint_as_float((unsigned)(w >> 32)); }
                t1 += __shfl_xor(t1, 16); t1 += __shfl_xor(t1, 32); t2 += __shfl_xor(t2, 16); t2 += __shfl_xor(t2, 32);
                const float mean = t1 * (1.0f / 4096.0f), var = fmaxf(t2 * (1.0f / 4096.0f) - mean * mean, 0.f), rstd = rsqrtf(var + 1e-6f);
                char* orow = ot + (size_t)(ai * 128 + m * 16) * DM * 4;
#pragma unroll
                for (int bj = 0; bj < 2; ++bj)
#pragma unroll
                    for (int n = 0; n < 2; ++n) { const f32x4 gg = *(const f32x4*)(lgt + coff + (bj * 128 + n * 16) * 4), bb = *(const f32x4*)(lbt + coff + (bj * 128 + n * 16) * 4);
                        *(f32x4*)(orow + loff + (bj * 128 + n * 16) * 4) = (acc[ai][bj][m][n] - mean) * rstd * gg + bb; }
                asm volatile("" ::: "memory"); }
        return false;
    }
};

DI void phase_adaln(const Params& p, float* mod, unsigned char* lds) {
    float* sc = (float*)lds;
    float* red = sc + 3 * 4096;
    const int tid = threadIdx.x;
    if ((int)blockIdx.x < 384) {
        for (int i = tid; i < 3 * 4096; i += NTHREADS) { const float v = (i < 8192) ? p.c[i] : p.c_ctx[i - 8192]; sc[i] = siluf_(v); }
    }
    __syncthreads();
    for (int item = blockIdx.x; item < 384; item += gridDim.x) {
        const int cc = tid & 31, rg = tid >> 5, col = item * 32 + cc;
        float a0 = 0.f, a1 = 0.f, a2 = 0.f;
#pragma unroll 8
        for (int r = rg; r < 4096; r += 16) { const float w = p.w_ada[(size_t)r * 12288 + col]; a0 += sc[r] * w; a1 += sc[4096 + r] * w; a2 += sc[8192 + r] * w; }
        red[(rg * 3 + 0) * 32 + cc] = a0; red[(rg * 3 + 1) * 32 + cc] = a1; red[(rg * 3 + 2) * 32 + cc] = a2;
        __syncthreads();
        if (tid < 96) { const int cnd = tid >> 5, c2 = tid & 31; float s = 0.f;
            for (int g = 0; g < 16; ++g) s += red[(g * 3 + cnd) * 32 + c2];
            mod[cnd * 12288 + item * 32 + c2] = s + p.b_ada[item * 32 + c2]; }
        __syncthreads();
    }
}
DI void transpose_tile(const float* src, bf16_t* dst, int K, int N, int kt, int nt, float* tl) {
    const int tid = threadIdx.x;
#pragma unroll
    for (int i = 0; i < 4; ++i) { const int row = (tid >> 4) + 32 * i, c4 = (tid & 15) * 4;
        const f32x4 v = *(const f32x4*)(src + (size_t)(kt * 128 + row) * N + nt * 64 + c4);
        tl[row * 65 + c4 + 0] = v[0]; tl[row * 65 + c4 + 1] = v[1]; tl[row * 65 + c4 + 2] = v[2]; tl[row * 65 + c4 + 3] = v[3]; }
    __syncthreads();
    { const int n = tid >> 3, kc = tid & 7; u32x4 w0, w1;
#pragma unroll
      for (int j = 0; j < 4; ++j) { w0[j] = cvt_pk_bf16(tl[(kc * 16 + 2 * j) * 65 + n], tl[(kc * 16 + 2 * j + 1) * 65 + n]);
                                    w1[j] = cvt_pk_bf16(tl[(kc * 16 + 8 + 2 * j) * 65 + n], tl[(kc * 16 + 8 + 2 * j + 1) * 65 + n]); }
      bf16_t* d = dst + (size_t)(nt * 64 + n) * K + kt * 128 + kc * 16;
      *(u32x4*)d = w0; *(u32x4*)(d + 8) = w1; }
    __syncthreads();
}
DI void phase_weights(const Params& p, unsigned char* lds) {
    float* tl = (float*)lds;
    bf16_t* WinT = (bf16_t*)(p.ws + WS_WIN); bf16_t* WpaT = (bf16_t*)(p.ws + WS_WPA); bf16_t* WpbT = (bf16_t*)(p.ws + WS_WPB); bf16_t* WoutT = (bf16_t*)(p.ws + WS_WOUT);
    constexpr int T_IN = 32 * 416, T_PA = 16 * 64, T_OUT = 32 * 64;
    for (int it = blockIdx.x; it < T_IN + 2 * T_PA + T_OUT; it += gridDim.x) {
        if (it < T_IN) transpose_tile(p.w_in, WinT, 4096, NIN, it / 416, it % 416, tl);
        else if (it < T_IN + T_PA) { const int j = it - T_IN; transpose_tile(p.w_pa, WpaT, 2048, 4096, j / 64, j % 64, tl); }
        else if (it < T_IN + 2 * T_PA) { const int j = it - T_IN - T_PA; transpose_tile(p.w_pb, WpbT, 2048, 4096, j / 64, j % 64, tl); }
        else { const int j = it - T_IN - 2 * T_PA; transpose_tile(p.w_out, WoutT, 4096, 4096, j / 64, j % 64, tl); }
    }
}

DI void phase_ln_mod(const Params& p, const float* mod, bf16_t* H) {
    const int wave = threadIdx.x >> 6, lane = threadIdx.x & 63;
    for (int row = blockIdx.x * 8 + wave; row < MROWS; row += gridDim.x * 8) {
        const float* src; int cnd;
        if (row < NLAT) { src = p.x + (size_t)row * DM; cnd = row >> 13; } else { src = p.ctx + (size_t)(row - NLAT) * DM; cnd = 2; }
        f32x4 v[16]; float s = 0.f;
#pragma unroll
        for (int i = 0; i < 16; ++i) { v[i] = ((const f32x4*)src)[i * 64 + lane]; s += (v[i][0] + v[i][1]) + (v[i][2] + v[i][3]); }
        s = wave_sum(s); const float mean = s * (1.0f / 4096.0f);
        float q = 0.f;
#pragma unroll
        for (int i = 0; i < 16; ++i) { const f32x4 d = v[i] - mean; q += (d[0] * d[0] + d[1] * d[1]) + (d[2] * d[2] + d[3] * d[3]); }
        q = wave_sum(q); const float rstd = rsqrtf(q * (1.0f / 4096.0f) + 1e-6f);
        const float* shift = mod + cnd * 12288; const float* scale = shift + 4096;
#pragma unroll
        for (int i = 0; i < 16; ++i) { const int col = (i * 64 + lane) * 4;
            const f32x4 sh = *(const f32x4*)(shift + col), sc = *(const f32x4*)(scale + col);
            const f32x4 hh = (v[i] - mean) * rstd * (sc + 1.0f) + sh;
            u32x2 w; w.x = cvt_pk_bf16(hh[0], hh[1]); w.y = cvt_pk_bf16(hh[2], hh[3]);
            *(u32x2*)(H + (size_t)row * DM + col) = w; }
    }
}

constexpr size_t WS_DEC = (size_t)2 * NLAT * 2048 * 4;
constexpr size_t WS_KUF = WS_DEC + (size_t)64 * 132 * 128 * 4;
constexpr size_t WS_KUC = WS_KUF + (size_t)32 * 128 * 16384;
static_assert(WS_KUC + (size_t)64 * 4 * 16384 <= WS_P, "hgrn scratch must fit before P");
DI float rcpf_(float v) { return __builtin_amdgcn_rcpf(v); }
DI unsigned char* hg_kut(const Params& p, int dir, int q, int n) {
    if (n < 4) return p.ws + WS_KUC + (size_t)((dir * 32 + q) * 4 + n) * 16384;
    return p.ws + (dir ? WS_YB : WS_KUF) + (size_t)(q * 128 + (n - 4)) * 16384;
}
DI unsigned char* hg_qc(const Params& p, int dir, int q, int n) { return p.ws + WS_M + (size_t)((dir * 32 + q) * 128 + (n - 4)) * 16384; }
DI float* hg_dec(const Params& p, int dir, int q, int n) { return (float*)(p.ws + WS_DEC) + (size_t)((dir * 32 + q) * 132 + n) * 128; }
#define HG_ROW0(n, b, dir, r0, sg) { int base_, len_, cn_; if ((n) < 4) { base_ = NLAT + (b) * LC; len_ = LC; cn_ = (n); } else { base_ = (b) * TT; len_ = TT; cn_ = (n) - 4; } \
        if (dir) { r0 = base_ + len_ - 1 - cn_ * 64; sg = -1; } else { r0 = base_ + cn_ * 64; sg = 1; } }

DI void hgrn_h1(const Params& p, unsigned char* lds) {
    const int tid = threadIdx.x, lane = tid & 63, w = tid >> 6, g = lane >> 4, c16 = lane & 15;
    const bf16_t* P = (const bf16_t*)(p.ws + WS_P);
    bf16_t* O = (bf16_t*)(p.ws + WS_O);
    bf16_t* Qa = (bf16_t*)lds;
    bf16_t* Kb = Qa + 64 * 136;
    bf16_t* Qc = Kb + 64 * 136;
    bf16_t* Vs = Qc + 64 * 136;
    bf16_t* Kut = Vs + 64 * 136;
    bf16_t* Am = Kut + 128 * 72;
    float* segtot = (float*)(Am + 64 * 72);
    LAS unsigned char* l3 = (LAS unsigned char*)lds;
    const unsigned vsb = 3 * 17408;
    const int d = tid & 127, seg = tid >> 7;
    const int lk0 = tid >> 4, ld8 = (tid & 15) * 8;
    const int ib = w >> 1, trq = c16 >> 2, trp = c16 & 3;
    bf16_t fraw[16], qraw[16]; u32x4 vraw[2];
#define H1_LOAD(it_) { const int n_ = (it_) % 132, sq_ = (it_) / 132, dir_ = sq_ & 1, q_ = sq_ >> 1, h_ = q_ & 15, b_ = q_ >> 4; int r0_, sg_; HG_ROW0(n_, b_, dir_, r0_, sg_); \
        const int colF_ = (dir_ ? C_FB : C_FF) + h_ * 128 + d, colQ_ = C_HQ + h_ * 128 + d; \
        _Pragma("unroll") for (int jj = 0; jj < 16; ++jj) { const int ro = r0_ + sg_ * (seg * 16 + jj); fraw[jj] = P[pix(ro, colF_)]; if (n_ >= 4) qraw[jj] = P[pix(ro, colQ_)]; } \
        if (n_ >= 4) { _Pragma("unroll") for (int i2 = 0; i2 < 2; ++i2) vraw[i2] = *(const u32x4*)(P + pix(r0_ + sg_ * (lk0 + 32 * i2), C_HI + h_ * 128 + ld8)); } }
    int it = blockIdx.x;
    if (it < 8448) H1_LOAD(it);
    for (; it < 8448; it += gridDim.x) {
        const int n = it % 132, sq = it / 132, dir = sq & 1, q = sq >> 1, h = q & 15, b = q >> 4;
        const bool lat = n >= 4;
        float lb;
        { const float* lbp = dir ? p.lb_bwd : p.lb_fwd; const float l0 = lbp[h * 128 + d], l1 = lbp[2048 + h * 128 + d]; lb = rcpf_(1.0f + __expf(l1 - l0)); }
        const float omlb = 1.0f - lb;
        float cl[16], kk[16], qs[16];
        float run = 1.f;
#pragma unroll
        for (int jj = 0; jj < 16; ++jj) { const float f = bf2f(fraw[jj]); const float sgm = rcpf_(1.0f + __expf(-f));
            kk[jj] = omlb * (1.0f - sgm); run *= lb + omlb * sgm; cl[jj] = run;
            qs[jj] = lat ? bf2f(qraw[jj]) : 0.f; }
        const u32x4 v0 = vraw[0], v1 = vraw[1];
        segtot[seg * 128 + d] = run;
        if (it + (int)gridDim.x < 8448) H1_LOAD(it + (int)gridDim.x);
        __syncthreads();
        {
            const float t0 = segtot[d], t1 = segtot[128 + d], t2 = segtot[256 + d], t3 = segtot[384 + d];
            const float ref = t0 * t1, elr = t2 * t3, last = ref * elr;
            const float offs = (seg == 0) ? 1.f : (seg == 1) ? t0 : (seg == 2) ? ref : ref * t2;
            const float rref = rcpf_(ref);
            unsigned kup[8];
#pragma unroll
            for (int jj = 0; jj < 16; jj += 2) {
                const float c0 = offs * cl[jj], c1 = offs * cl[jj + 1];
                const float e0 = c0 * rref, e1 = c1 * rref;
                const float i0 = ref * rcpf_(c0), i1 = ref * rcpf_(c1);
                kup[jj >> 1] = cvt_pk_bf16(kk[jj] * i0 * elr, kk[jj + 1] * i1 * elr);
                if (lat) {
                    const int r0 = (seg * 16 + jj) * 136 + d, r1 = r0 + 136;
                    const unsigned wa = cvt_pk_bf16(qs[jj] * e0, qs[jj + 1] * e1), wc2 = cvt_pk_bf16(qs[jj] * c0, qs[jj + 1] * c1), wk = cvt_pk_bf16(kk[jj] * i0, kk[jj + 1] * i1);
                    Qa[r0] = (bf16_t)(wa & 0xffffu); Qa[r1] = (bf16_t)(wa >> 16);
                    Qc[r0] = (bf16_t)(wc2 & 0xffffu); Qc[r1] = (bf16_t)(wc2 >> 16);
                    Kb[r0] = (bf16_t)(wk & 0xffffu); Kb[r1] = (bf16_t)(wk >> 16); }
            }
            *(u32x4*)(Kut + d * 72 + seg * 16) = (u32x4){kup[0], kup[1], kup[2], kup[3]};
            *(u32x4*)(Kut + d * 72 + seg * 16 + 8) = (u32x4){kup[4], kup[5], kup[6], kup[7]};
            if (seg == 0) hg_dec(p, dir, q, n)[d] = last;
            if (lat) { *(u32x4*)(Vs + lk0 * 136 + ld8) = v0; *(u32x4*)(Vs + (lk0 + 32) * 136 + ld8) = v1; }
        }
        __syncthreads();
        {
            bf16_t* kg = (bf16_t*)hg_kut(p, dir, q, n);
#pragma unroll
            for (int i2 = 0; i2 < 2; ++i2) { const int ch = tid + 512 * i2, row = ch >> 3, c8 = (ch & 7) * 8; *(u32x4*)(kg + row * 64 + c8) = *(const u32x4*)(Kut + row * 72 + c8); }
            if (lat) { bf16_t* qg = (bf16_t*)hg_qc(p, dir, q, n);
#pragma unroll
                for (int i2 = 0; i2 < 2; ++i2) { const int ch = tid + 512 * i2, row = ch >> 4, c8 = (ch & 15) * 8; *(u32x4*)(qg + row * 128 + c8) = *(const u32x4*)(Qc + row * 136 + c8); } }
        }
        if (lat) {
#pragma unroll
            for (int q2 = 0; q2 < 2; ++q2) { const int sb = (w & 1) * 2 + q2;
                f32x4 a = (f32x4){0.f, 0.f, 0.f, 0.f};
                if (sb <= ib) {
#pragma unroll
                    for (int ks = 0; ks < 4; ++ks) { const bf16x8 fa = *(const bf16x8*)(Qa + (ib * 16 + c16) * 136 + ks * 32 + g * 8), fb = *(const bf16x8*)(Kb + (sb * 16 + c16) * 136 + ks * 32 + g * 8);
                        a = MFMA16(fa, fb, a); }
                }
#pragma unroll
                for (int j = 0; j < 4; ++j) { const int ii = ib * 16 + g * 4 + j, ss = sb * 16 + c16; Am[ii * 72 + ss] = f2bf((ss <= ii) ? a[j] : 0.f); }
            }
        }
        __syncthreads();
        if (lat) {
            int r0, sg; HG_ROW0(n, b, dir, r0, sg);
#pragma unroll
            for (int cc = 0; cc < 4; ++cc) { const int c = (w & 1) * 4 + cc;
                f32x4 o = (f32x4){0.f, 0.f, 0.f, 0.f};
#pragma unroll
                for (int ks = 0; ks < 2; ++ks) {
                    if (ks == 1 && ib < 2) continue;
                    const bf16x8 fa = *(const bf16x8*)(Am + (ib * 16 + c16) * 72 + ks * 32 + g * 8);
                    const s16x4 lo = __builtin_amdgcn_ds_read_tr16_b64_v4i16((LAS s16x4*)(l3 + vsb + (32 * ks + 8 * g + trq) * 272 + 32 * c + 8 * trp));
                    const s16x4 hi = __builtin_amdgcn_ds_read_tr16_b64_v4i16((LAS s16x4*)(l3 + vsb + (32 * ks + 8 * g + 4 + trq) * 272 + 32 * c + 8 * trp));
                    o = MFMA16(__builtin_shufflevector(lo, hi, 0, 1, 2, 3, 4, 5, 6, 7), fa, o); }
                u32x2 ow;
                ow.x = (unsigned)f2bf(o[0]) | ((unsigned)f2bf(o[1]) << 16); ow.y = (unsigned)f2bf(o[2]) | ((unsigned)f2bf(o[3]) << 16);
                *(u32x2*)(O + oix(dir, r0 + sg * (ib * 16 + c16), h, c * 16 + 4 * g)) = ow;
            }
        }
    }
    __syncthreads();
#undef H1_LOAD
}

DI void hgrn_h2(const Params& p, int it, unsigned char* lds) {
    const int tid = threadIdx.x, lane = tid & 63, w = tid >> 6, g = lane >> 4, c16 = lane & 15;
    const int dvq = it & 3, dir = (it >> 2) & 1, h = (it >> 3) & 15, b = it >> 7, q = b * 16 + h;
    const bf16_t* P = (const bf16_t*)(p.ws + WS_P);
    bf16_t* O = (bf16_t*)(p.ws + WS_O);
    bf16_t* L = (bf16_t*)lds;
    LAS unsigned char* l3 = (LAS unsigned char*)lds;
    bf16_t* Stb = (bf16_t*)(lds + 81920);
    const int ib = w >> 1, vb = w & 1, trq = c16 >> 2, trp = c16 & 3;
    const int vs = tid >> 2, vc8 = (tid & 3) * 8;
    for (int i = tid; i < 2 * 32 * 136; i += NTHREADS) Stb[i] = 0;
    f32x4 Sreg[2]; Sreg[0] = (f32x4){0.f, 0.f, 0.f, 0.f}; Sreg[1] = Sreg[0];
    u32x4 kur[2], qcr[2], vqr; float decr[2], decc[2]; u32x2 oinr, oinc;
#define H2_LOAD(n_) { int r0_, sg_; HG_ROW0(n_, b, dir, r0_, sg_); \
        const bf16_t* kg_ = (const bf16_t*)hg_kut(p, dir, q, n_); \
        _Pragma("unroll") for (int i2 = 0; i2 < 2; ++i2) { const int ch = tid + 512 * i2; kur[i2] = *(const u32x4*)(kg_ + (ch >> 3) * 64 + (ch & 7) * 8); } \
        if (tid < 256) vqr = *(const u32x4*)(P + pix(r0_ + sg_ * vs, C_HI + h * 128 + dvq * 32 + vc8)); \
        const float* dg_ = hg_dec(p, dir, q, n_); decr[0] = dg_[((w >> 1) * 2) * 16 + c16]; decr[1] = dg_[((w >> 1) * 2 + 1) * 16 + c16]; \
        if ((n_) >= 4) { const bf16_t* qg_ = (const bf16_t*)hg_qc(p, dir, q, n_); \
            _Pragma("unroll") for (int i2 = 0; i2 < 2; ++i2) { const int ch = tid + 512 * i2; qcr[i2] = *(const u32x4*)(qg_ + (ch >> 4) * 128 + (ch & 15) * 8); } \
            oinr = *(const u32x2*)(O + oix(dir, r0_ + sg_ * (ib * 16 + c16), h, dvq * 32 + vb * 16 + 4 * g)); } }
#define H2_WRITE(bf_) { bf16_t* B_ = L + (bf_) * 20480; \
        _Pragma("unroll") for (int i2 = 0; i2 < 2; ++i2) { const int ch = tid + 512 * i2; *(u32x4*)(B_ + (ch >> 3) * 72 + (ch & 7) * 8) = kur[i2]; *(u32x4*)(B_ + 9216 + (ch >> 4) * 136 + (ch & 15) * 8) = qcr[i2]; } \
        if (tid < 256) *(u32x4*)(B_ + 9216 + 8704 + vs * 40 + vc8) = vqr; }
    qcr[0] = (u32x4){0u, 0u, 0u, 0u}; qcr[1] = qcr[0];
    H2_LOAD(0); H2_WRITE(0);
#pragma unroll
    for (int j = 0; j < 2; ++j) decc[j] = decr[j];
    oinr = (u32x2){0u, 0u}; oinc = oinr;
    H2_LOAD(1);
    __syncthreads();
    for (int n = 0; n < 132; ++n) {
        const int cur = n & 1;
        const bf16_t* Bc = L + cur * 20480;
        const bf16_t* KutS = Bc; const bf16_t* QcS = Bc + 9216;
        const unsigned vqb = (unsigned)(cur * 40960 + (9216 + 8704) * 2);
        const bf16_t* Sc = Stb + cur * 4352; bf16_t* Sn = Stb + (cur ^ 1) * 4352;
        f32x4 u[2];
#pragma unroll
        for (int q2 = 0; q2 < 2; ++q2) { const int db = (w >> 1) * 2 + q2; u[q2] = (f32x4){0.f, 0.f, 0.f, 0.f};
#pragma unroll
            for (int ks = 0; ks < 2; ++ks) {
                const s16x4 lo = __builtin_amdgcn_ds_read_tr16_b64_v4i16((LAS s16x4*)(l3 + vqb + (32 * ks + 8 * g + trq) * 80 + 32 * vb + 8 * trp));
                const s16x4 hi = __builtin_amdgcn_ds_read_tr16_b64_v4i16((LAS s16x4*)(l3 + vqb + (32 * ks + 8 * g + 4 + trq) * 80 + 32 * vb + 8 * trp));
                const bf16x8 fb = *(const bf16x8*)(KutS + (db * 16 + c16) * 72 + ks * 32 + g * 8);
                u[q2] = MFMA16(__builtin_shufflevector(lo, hi, 0, 1, 2, 3, 4, 5, 6, 7), fb, u[q2]); } }
        if (n >= 4) {
            f32x4 oacc = (f32x4){0.f, 0.f, 0.f, 0.f};
#pragma unroll
            for (int ks = 0; ks < 4; ++ks) { const bf16x8 fa = *(const bf16x8*)(QcS + (ib * 16 + c16) * 136 + ks * 32 + g * 8), fb = *(const bf16x8*)(Sc + (vb * 16 + c16) * 136 + ks * 32 + g * 8);
                oacc = MFMA16(fb, fa, oacc); }
            int r0, sg; HG_ROW0(n, b, dir, r0, sg);
            u32x2 ow; ow.x = cvt_pk_bf16(bflo(oinc.x) + oacc[0], bfhi(oinc.x) + oacc[1]); ow.y = cvt_pk_bf16(bflo(oinc.y) + oacc[2], bfhi(oinc.y) + oacc[3]);
            *(u32x2*)(O + oix(dir, r0 + sg * (ib * 16 + c16), h, dvq * 32 + vb * 16 + 4 * g)) = ow;
        }
#pragma unroll
        for (int q2 = 0; q2 < 2; ++q2) { const int db = (w >> 1) * 2 + q2;
            Sreg[q2] = Sreg[q2] * decc[q2] + u[q2];
#pragma unroll
            for (int j = 0; j < 4; ++j) Sn[(vb * 16 + g * 4 + j) * 136 + db * 16 + c16] = f2bf(Sreg[q2][j]); }
        if (n + 1 < 132) { H2_WRITE(cur ^ 1);
#pragma unroll
            for (int j = 0; j < 2; ++j) decc[j] = decr[j];
            oinc = oinr; }
        if (n + 2 < 132) H2_LOAD(n + 2);
        __syncthreads();
    }
#undef H2_LOAD
#undef H2_WRITE
}

typedef float f32x16 __attribute__((ext_vector_type(16)));
#define MFMA32(a, b, c) __builtin_amdgcn_mfma_f32_32x32x16_bf16((a), (b), (c), 0, 0, 0)
DI float xchg32(float v) {
    const unsigned u = __float_as_uint(v);
    const auto r = __builtin_amdgcn_permlane32_swap(u, u, false, false);
    return __uint_as_float((threadIdx.x & 32) ? r[0] : r[1]);
}
DI int clamp_rs(int r) { return min(max(r - 4, 0), 120); }
DI void attn_item(const Params& p, int it, unsigned char* lds) {
    const int tid = threadIdx.x, lane = tid & 63, w = tid >> 6, r32 = lane & 31, hh = lane >> 5;
    const int rq4 = it & 31, h = (it >> 5) & 15, b = it >> 9;
    const int cq = w & 3, rlo = 4 * rq4 + 2 * (w >> 2);
    const int rr = rlo + (r32 >> 4);
    const bf16_t* P = (const bf16_t*)(p.ws + WS_P);
    bf16_t* YA = (bf16_t*)(p.ws + WS_YA);
    bf16_t* KV = (bf16_t*)lds;
    LAS unsigned char* l3 = (LAS unsigned char*)lds;
    float* rp = (float*)(lds + 2 * 34816);
    const int rs0 = clamp_rs(4 * rq4), rs3 = clamp_rs(4 * rq4 + 3), nloc = rs3 + 8 - rs0, nt = nloc + 4;
    const int rsl = clamp_rs(rr);
    const int rsw0 = clamp_rs(rlo), rsw1 = clamp_rs(rlo + 1) + 8;
    for (int i = tid; i < 704; i += NTHREADS) rp[i] = (i >= 96 && i < 96 + 465) ? p.rpb[h * 465 + i - 96] * 1.4426950408889634f : 0.f;
    const int qc = 16 * cq + (r32 & 15), qrow = b * TT + rr * 64 + qc;
    const int cs = min(max(qc - 8, 0), 48);
    const int koff = min(max(16 * cq - 8, 0), 32);
    bf16x8 qf[8];
#pragma unroll
    for (int s2 = 0; s2 < 8; ++s2) qf[s2] = *(const bf16x8*)(P + pix(qrow, C_Q + h * 128 + 16 * s2 + 8 * hh));
    unsigned okmask = 0u;
#pragma unroll
    for (int k = 0; k < 16; ++k) { const int kc = koff + (k & 3) + 8 * (k >> 2) + 4 * hh; okmask |= ((kc >= cs) && (kc < cs + 16)) ? (1u << k) : 0u; }
    const int lk0 = tid >> 4, ld8 = (tid & 15) * 8;
    u32x4 kreg[2], vreg[2];
#define AT_LOAD(t) { const int rowb = ((t) < nloc) ? (b * TT + (rs0 + (t)) * 64) : (NLAT + b * LC + ((t) - nloc) * 64); \
        _Pragma("unroll") for (int i2 = 0; i2 < 2; ++i2) { const int kr_ = rowb + lk0 + 32 * i2; \
            kreg[i2] = *(const u32x4*)(P + pix(kr_, C_K + h * 128 + ld8)); vreg[i2] = *(const u32x4*)(P + pix(kr_, C_V + h * 128 + ld8)); } }
#define AT_WRITE(buf) { bf16_t* Kd = KV + (buf) * 17408; \
        _Pragma("unroll") for (int i2 = 0; i2 < 2; ++i2) { *(u32x4*)(Kd + (lk0 + 32 * i2) * 136 + ld8) = kreg[i2]; *(u32x4*)(Kd + 8704 + (lk0 + 32 * i2) * 136 + ld8) = vreg[i2]; } }
    AT_LOAD(0); AT_WRITE(0); AT_LOAD(1);
    float m_run = -1e30f, l_part = 0.f;
    f32x16 oa[4];
#pragma unroll
    for (int c = 0; c < 4; ++c)
#pragma unroll
        for (int i = 0; i < 16; ++i) oa[c][i] = 0.f;
    const float scale2 = 0.08838834764831845f * 1.4426950408889634f;
    const int blk = (lane >> 4) & 1, trq = (lane & 15) >> 2, trp = lane & 3;
    const unsigned troff = (unsigned)((4 * hh + trq) * 272 + 32 * blk + 8 * trp);
    __syncthreads();
    for (int t = 0; t < nt; ++t) {
        const bool local = t < nloc;
        const int kr = rs0 + t;
        const bool rowok = !local || ((kr >= rsw0) && (kr < rsw1));
        const int kbase = local ? koff : 0;
        const bf16_t* Ks = KV + (t & 1) * 17408 + kbase * 136;
        const unsigned vsb = (unsigned)((t & 1) * 34816 + 17408 + kbase * 272);
        if (rowok) {
            f32x16 sa[2];
            float bv[16];
            {
                bf16x8 kf[8];
#pragma unroll
                for (int s2 = 0; s2 < 8; ++s2) kf[s2] = *(const bf16x8*)(Ks + r32 * 136 + 16 * s2 + 8 * hh);
                if (local) {
                    const float* bp = rp + ((kr - rr + 7) * 31 + 111 - qc + koff + 4 * hh);
#pragma unroll
                    for (int k = 0; k < 16; ++k) bv[k] = bp[(k & 3) + 8 * (k >> 2)];
                } else {
#pragma unroll
                    for (int k = 0; k < 16; ++k) bv[k] = 0.f;
                }
                __builtin_amdgcn_sched_barrier(0);
#pragma unroll
                for (int i = 0; i < 16; ++i) { sa[0][i] = 0.f; sa[1][i] = 0.f; }
#pragma unroll
                for (int s2 = 0; s2 < 8; ++s2) sa[0] = MFMA32(kf[s2], qf[s2], sa[0]);
                if (!local) {
                    __builtin_amdgcn_sched_barrier(0);
#pragma unroll
                    for (int s2 = 0; s2 < 8; ++s2) kf[s2] = *(const bf16x8*)(Ks + (32 + r32) * 136 + 16 * s2 + 8 * hh);
                    __builtin_amdgcn_sched_barrier(0);
#pragma unroll
                    for (int s2 = 0; s2 < 8; ++s2) sa[1] = MFMA32(kf[s2], qf[s2], sa[1]);
                }
            }
            float mx = -INFINITY;
            if (local) {
                const bool lrow = (kr >= rsl) && (kr < rsl + 8);
                const unsigned om = lrow ? okmask : 0u;
#pragma unroll
                for (int i = 0; i < 16; ++i) {
                    const float v0 = sa[0][i] * scale2 + bv[i];
                    const float v = ((om >> i) & 1u) ? v0 : -INFINITY;
                    sa[0][i] = v; mx = fmaxf(mx, v); }
            } else {
#pragma unroll
                for (int kb = 0; kb < 2; ++kb)
#pragma unroll
                    for (int i = 0; i < 16; ++i) { const float v = sa[kb][i] * scale2; sa[kb][i] = v; mx = fmaxf(mx, v); }
            }
            mx = fmaxf(mx, xchg32(mx));
            const float m_new = fmaxf(m_run, mx), alpha = __builtin_amdgcn_exp2f(m_run - m_new);
            float lsum = 0.f;
#pragma unroll
            for (int i = 0; i < 16; ++i) { const float pv = __builtin_amdgcn_exp2f(sa[0][i] - m_new); sa[0][i] = pv; lsum += pv; }
            if (!local) {
#pragma unroll
                for (int i = 0; i < 16; ++i) { const float pv = __builtin_amdgcn_exp2f(sa[1][i] - m_new); sa[1][i] = pv; lsum += pv; } }
            l_part = l_part * alpha + lsum; m_run = m_new;
            if (__any(alpha != 1.0f)) {
#pragma unroll
                for (int c = 0; c < 4; ++c) oa[c] = oa[c] * alpha; }
#pragma unroll
            for (int kb = 0; kb < 2; ++kb) {
                if (kb == 1 && local) continue;
                bf16x8 pb[2];
#pragma unroll
                for (int s2 = 0; s2 < 2; ++s2) {
                    const u32x4 pw = (u32x4){cvt_pk_bf16(sa[kb][8 * s2 + 0], sa[kb][8 * s2 + 1]), cvt_pk_bf16(sa[kb][8 * s2 + 2], sa[kb][8 * s2 + 3]),
                                             cvt_pk_bf16(sa[kb][8 * s2 + 4], sa[kb][8 * s2 + 5]), cvt_pk_bf16(sa[kb][8 * s2 + 6], sa[kb][8 * s2 + 7])};
                    pb[s2] = __builtin_bit_cast(bf16x8, pw); }
                s16x4 tl[2][4], th[2][4];
#pragma unroll
                for (int s2 = 0; s2 < 2; ++s2)
#pragma unroll
                    for (int c = 0; c < 4; ++c) {
                        tl[s2][c] = __builtin_amdgcn_ds_read_tr16_b64_v4i16((LAS s16x4*)(l3 + vsb + troff + (32 * kb + 16 * s2) * 272 + 64 * c));
                        th[s2][c] = __builtin_amdgcn_ds_read_tr16_b64_v4i16((LAS s16x4*)(l3 + vsb + troff + (32 * kb + 16 * s2 + 8) * 272 + 64 * c)); }
                __builtin_amdgcn_sched_barrier(0);
#pragma unroll
                for (int s2 = 0; s2 < 2; ++s2)
#pragma unroll
                    for (int c = 0; c < 4; ++c) oa[c] = MFMA32(__builtin_shufflevector(tl[s2][c], th[s2][c], 0, 1, 2, 3, 4, 5, 6, 7), pb[s2], oa[c]);
            }
        }
        if (t + 1 < nt) AT_WRITE((t + 1) & 1);
        if (t + 2 < nt) AT_LOAD(t + 2);
        __syncthreads();
    }
    {
        const float inv = 1.0f / (l_part + xchg32(l_part));
        const size_t zo = pix(qrow, C_Z + h * 128); const size_t yo = (size_t)qrow * 2048 + h * 128;
#pragma unroll
        for (int c = 0; c < 4; ++c)
#pragma unroll
            for (int i4 = 0; i4 < 4; ++i4) { const int dv = 32 * c + 8 * i4 + 4 * hh;
                const u32x2 zz = *(const u32x2*)(P + zo + dv);
                const float o0 = oa[c][4 * i4 + 0] * inv * siluf_(bflo(zz.x)), o1 = oa[c][4 * i4 + 1] * inv * siluf_(bfhi(zz.x));
                const float o2 = oa[c][4 * i4 + 2] * inv * siluf_(bflo(zz.y)), o3 = oa[c][4 * i4 + 3] * inv * siluf_(bfhi(zz.y));
                u32x2 wv; wv.x = cvt_pk_bf16(o0, o1); wv.y = cvt_pk_bf16(o2, o3);
                *(u32x2*)(YA + yo + dv) = wv; }
    }
#undef AT_LOAD
#undef AT_WRITE
}

DI void phase_readout(const Params& p) {
    const bf16_t* P = (const bf16_t*)(p.ws + WS_P);
    const bf16_t* O = (const bf16_t*)(p.ws + WS_O);
    bf16_t* YB = (bf16_t*)(p.ws + WS_YB);
    const int total = NLAT * 256;
    for (int idx = blockIdx.x * NTHREADS + threadIdx.x; idx < total; idx += gridDim.x * NTHREADS) {
        const int tok = idx >> 8, col = (idx & 255) * 8;
        const u32x4 af = *(const u32x4*)(O + oix(0, tok, col >> 7, col & 127)), ab = *(const u32x4*)(O + oix(1, tok, col >> 7, col & 127));
        const f32x4 o0 = (f32x4){bflo(af.x) + bflo(ab.x), bfhi(af.x) + bfhi(ab.x), bflo(af.y) + bflo(ab.y), bfhi(af.y) + bfhi(ab.y)};
        const f32x4 o1 = (f32x4){bflo(af.z) + bflo(ab.z), bfhi(af.z) + bfhi(ab.z), bflo(af.w) + bflo(ab.w), bfhi(af.w) + bfhi(ab.w)};
        float ss = (o0[0] * o0[0] + o0[1] * o0[1]) + (o0[2] * o0[2] + o0[3] * o0[3]) + (o1[0] * o1[0] + o1[1] * o1[1]) + (o1[2] * o1[2] + o1[3] * o1[3]);
        ss += __shfl_xor(ss, 1); ss += __shfl_xor(ss, 2); ss += __shfl_xor(ss, 4); ss += __shfl_xor(ss, 8);
        const float rr = rsqrtf(ss * (1.0f / 128.0f) + 1e-6f);
        const int v0 = col & 127;
        const f32x4 n0 = *(const f32x4*)(p.hg_nw + v0), n1 = *(const f32x4*)(p.hg_nw + v0 + 4);
        const u32x4 gg = *(const u32x4*)(P + pix(tok, C_HG + col));
        u32x4 wv;
        wv.x = cvt_pk_bf16(o0[0] * rr * n0[0] * siluf_(bflo(gg.x)), o0[1] * rr * n0[1] * siluf_(bfhi(gg.x)));
        wv.y = cvt_pk_bf16(o0[2] * rr * n0[2] * siluf_(bflo(gg.y)), o0[3] * rr * n0[3] * siluf_(bfhi(gg.y)));
        wv.z = cvt_pk_bf16(o1[0] * rr * n1[0] * siluf_(bflo(gg.z)), o1[1] * rr * n1[1] * siluf_(bfhi(gg.z)));
        wv.w = cvt_pk_bf16(o1[2] * rr * n1[2] * siluf_(bflo(gg.w)), o1[3] * rr * n1[3] * siluf_(bfhi(gg.w)));
        *(u32x4*)(YB + (size_t)tok * 2048 + col) = wv;
    }
}

DI void phase_final_ln(const Params& p) {
    const int wave = threadIdx.x >> 6, lane = threadIdx.x & 63;
    for (int row = blockIdx.x * 8 + wave; row < NLAT; row += gridDim.x * 8) {
        float* src = p.out + (size_t)row * DM;
        f32x4 v[16]; float s = 0.f;
#pragma unroll
        for (int i = 0; i < 16; ++i) { v[i] = ((const f32x4*)src)[i * 64 + lane]; s += (v[i][0] + v[i][1]) + (v[i][2] + v[i][3]); }
        s = wave_sum(s); const float mean = s * (1.0f / 4096.0f);
        float q = 0.f;
#pragma unroll
        for (int i = 0; i < 16; ++i) { const f32x4 d = v[i] - mean; q += (d[0] * d[0] + d[1] * d[1]) + (d[2] * d[2] + d[3] * d[3]); }
        q = wave_sum(q); const float rstd = rsqrtf(q * (1.0f / 4096.0f) + 1e-6f);
#pragma unroll
        for (int i = 0; i < 16; ++i) { const int col = (i * 64 + lane) * 4;
            const f32x4 gg = *(const f32x4*)(p.ln_g + col), bb = *(const f32x4*)(p.ln_b + col);
            ((f32x4*)src)[i * 64 + lane] = (v[i] - mean) * rstd * gg + bb; }
    }
}

#define XB_TMO      128
#define XB_XCNT(j)  (256  + 64 * (j))
#define XB_XSUB(j)  (1280 + 64 * (j))
#define XB_XGEN(j)  (2304 + 64 * (j))
#define XB_TOP      3328
#define XB_TOPGEN   3392
#define XCD_BAR_WORDS 3456
#define XB_SPIN_CAP (1u << 18)
DI unsigned xb_ld(unsigned* p) { return __hip_atomic_load(p, __ATOMIC_RELAXED, __HIP_MEMORY_SCOPE_AGENT); }
DI unsigned xb_add(unsigned* p, unsigned v) { return __hip_atomic_fetch_add(p, v, __ATOMIC_RELAXED, __HIP_MEMORY_SCOPE_AGENT); }
DI unsigned xb_xcc_id() { return (unsigned)__builtin_amdgcn_s_getreg((3 << 11) | 20) & 0xFu; }
#define XB_SPIN(cond, bar) do { unsigned _sp = 0; while (cond) { __builtin_amdgcn_s_sleep(1); \
    if ((++_sp & 255u) == 0u) { if (xb_ld(&(bar)[XB_TMO])) break; if (_sp > XB_SPIN_CAP) { atomicAdd(&(bar)[XB_TMO], 1u); break; } } } } while (0)
struct XcdBarrier { unsigned* bar; unsigned x; volatile LAS unsigned* st; };
DI XcdBarrier xcd_barrier_post(unsigned* bar, volatile LAS unsigned* st) {
    XcdBarrier b; b.bar = bar; b.x = xb_xcc_id(); b.st = st;
    if (threadIdx.x == 0) (void)xb_add(&bar[XB_XCNT(b.x)], 1u);
    return b;
}
DI void xcd_barrier_complete(unsigned* bar, unsigned x, unsigned& nloc, unsigned& nx) {
    const unsigned G = gridDim.x * gridDim.y * gridDim.z;
    unsigned sum, cnt, mine, sp = 0u;
    for (;;) {
        sum = 0u; cnt = 0u; mine = 0u;
#pragma unroll
        for (unsigned j = 0; j < 16; ++j) { const unsigned c = xb_ld(&bar[XB_XCNT(j)]); sum += c; cnt += (c > 0u) ? 1u : 0u; mine = (j == x) ? c : mine; }
        if (sum == G) break;
        __builtin_amdgcn_s_sleep(1);
        if ((++sp & 255u) == 0u) { if (xb_ld(&bar[XB_TMO])) break; if (sp > XB_SPIN_CAP) { atomicAdd(&bar[XB_TMO], 1u); break; } }
    }
    nloc = mine > 0u ? mine : 1u; nx = cnt > 0u ? cnt : 1u;
}
DI void xcd_barrier(const XcdBarrier& b) {
    asm volatile("s_waitcnt vmcnt(0)" ::: "memory");
    __syncthreads();
    if (threadIdx.x == 0) {
        unsigned* bar = b.bar;
        __builtin_amdgcn_s_waitcnt(0);
        unsigned nloc = b.st[0], nx = b.st[1];
        if (nloc == 0u) { xcd_barrier_complete(bar, b.x, nloc, nx); b.st[0] = nloc; b.st[1] = nx; }
        const unsigned old = xb_add(&bar[XB_XSUB(b.x)], 1u);
        const unsigned gen = old / nloc;
        if (old + 1u == (gen + 1u) * nloc) {
            __builtin_amdgcn_fence(__ATOMIC_RELEASE, "agent");
            asm volatile("s_waitcnt vmcnt(0)" ::: "memory");
            const unsigned og = xb_add(&bar[XB_TOP], 1u);
            const unsigned tg = og / nx;
            if (og + 1u == (tg + 1u) * nx) xb_add(&bar[XB_TOPGEN], 1u);
            else XB_SPIN(xb_ld(&bar[XB_TOPGEN]) == tg, bar);
            __builtin_amdgcn_fence(__ATOMIC_ACQUIRE, "agent");
            xb_add(&bar[XB_XGEN(b.x)], 1u);
            asm volatile("s_waitcnt vmcnt(0)" ::: "memory");
        } else {
            XB_SPIN(xb_ld(&bar[XB_XGEN(b.x)]) == gen, bar);
            __builtin_amdgcn_fence(__ATOMIC_ACQUIRE, "agent");
            asm volatile("s_waitcnt vmcnt(0)" ::: "memory");
        }
    }
    __syncthreads();
}

__global__ void __launch_bounds__(NTHREADS, 2) fwd_megakernel(Params p) {
    extern __shared__ __attribute__((aligned(16))) unsigned char lds[];
    cg::grid_group grid = cg::this_grid();
    const int lo = p.ph_lo, hi = p.ph_hi;
    if (lo < 0) grid.sync();
    volatile LAS unsigned* bst = (volatile LAS unsigned*)((LAS unsigned char*)lds + (LDS_BYTES - 16));
    if (threadIdx.x < 4) bst[threadIdx.x] = 0u;
    __syncthreads();
    XcdBarrier xbar = xcd_barrier_post((unsigned*)(p.ws + WS_BAR), bst);
#define IN(k) (lo <= (k) && (k) < hi)
#define SEAM(k) do { if (IN(k) && IN((k) + 1)) xcd_barrier(xbar); } while (0)
    float* mod = (float*)(p.ws + WS_MOD);
    const bool fuse_ln = (gridDim.x == 256) && IN(6) && IN(7);
    bf16_t* H = (bf16_t*)(p.ws + WS_H);
    bf16_t* Pb = (bf16_t*)(p.ws + WS_P);
    if (IN(0)) { phase_adaln(p, mod, lds); phase_weights(p, lds); }
    SEAM(0);
    if (IN(1)) phase_ln_mod(p, mod, H);
    SEAM(1);
    if (IN(2)) {
        const bf16_t* WinT = (const bf16_t*)(p.ws + WS_WIN);
        pg8::Gemm g{H, WinT, nullptr, nullptr, NLAT, NIN, DM, DM};
        pg8::StaticOrder<1> S; S.init(NLAT, NIN, gridDim.x, blockIdx.x);
        EpiP E{Pb};
        pg8::gemm_phase<EpiP, pg8::StaticOrder<1>>((LAS unsigned char*)lds, g, S, E);
        float* SC = (float*)(p.ws + WS_M);
        pg8::Gemm gc{H, WinT, H + 2048, WinT + 2048, MROWS, NIN, 2048, DM};
        CtxOrder Sx{(int)blockIdx.x, (int)gridDim.x};
        EpiCtx Ec{SC};
        pg8::gemm_phase<EpiCtx, CtxOrder>((LAS unsigned char*)lds, gc, Sx, Ec);
        xcd_barrier(xbar);
        ctx_combine(p, SC, Pb);
    }
    SEAM(2);
    if (IN(3)) {
        hgrn_h1(p, lds);
        xcd_barrier(xbar);
        const int cx = ((gridDim.x & 7) == 0) ? (int)((blockIdx.x & 7) * (gridDim.x >> 3) + (blockIdx.x >> 3)) : (int)blockIdx.x;
        for (int it = cx; it < 256; it += gridDim.x) hgrn_h2(p, it, lds);
        for (int it = cx; it < 1024; it += gridDim.x) attn_item(p, it, lds);
    }
    SEAM(3);
    if (IN(4)) phase_readout(p);
    SEAM(4);
    if (IN(5)) {
        pg8::Gemm g{(const bf16_t*)(p.ws + WS_YA), (const bf16_t*)(p.ws + WS_WPA), (const bf16_t*)(p.ws + WS_YB), (const bf16_t*)(p.ws + WS_WPB), NLAT, DM, 2048, 2048};
        pg8::StaticOrder<2> S; S.init(NLAT, DM, gridDim.x, blockIdx.x);
        EpiM E{Pb, (bf16_t*)(p.ws + WS_M)};
        pg8::gemm_phase<EpiM, pg8::StaticOrder<2>>((LAS unsigned char*)lds, g, S, E);
    }
    SEAM(5);
    if (IN(6)) {
        pg8::Gemm g{(const bf16_t*)(p.ws + WS_M), (const bf16_t*)(p.ws + WS_WOUT), nullptr, nullptr, NLAT, DM, DM, DM};
        if (fuse_ln) {
            RowBlockOrder S; S.init(blockIdx.x);
            EpiLnOut E{p.x, mod, p.ln_g, p.ln_b, p.out, (unsigned long long*)(p.ws + WS_SLOT), (unsigned*)(p.ws + WS_CNT), (LAS unsigned char*)lds + 131072};
            pg8::gemm_phase<EpiLnOut, RowBlockOrder>((LAS unsigned char*)lds, g, S, E);
        } else {
            pg8::StaticOrder<1> S; S.init(NLAT, DM, gridDim.x, blockIdx.x);
            EpiOut E{p.x, mod, p.out};
            pg8::gemm_phase<EpiOut, pg8::StaticOrder<1>>((LAS unsigned char*)lds, g, S, E);
        }
    }
    if (!fuse_ln) { SEAM(6); if (IN(7)) phase_final_ln(p); }
#undef IN
#undef SEAM
}

extern "C" void kernel_launch(void* const* d_in, const int* in_sizes, int n_in, void* d_out, int out_size, void* d_ws, size_t ws_size, hipStream_t stream) {
    static int grid = 0;
    if (grid == 0) {
        if (n_in != 16 || ws_size < WS_END) { fprintf(stderr, "kernel_launch: bad n_in %d or ws_size %zu < %zu\n", n_in, ws_size, (size_t)WS_END); grid = -1; return; }
        int dev = 0, cus = 0, per_cu = 0;
        hipGetDevice(&dev);
        hipDeviceGetAttribute(&cus, hipDeviceAttributeMultiprocessorCount, dev);
        if (hipFuncSetAttribute((const void*)fwd_megakernel, hipFuncAttributeMaxDynamicSharedMemorySize, LDS_BYTES) != hipSuccess) { fprintf(stderr, "kernel_launch: hipFuncSetAttribute failed\n"); grid = -1; return; }
        hipOccupancyMaxActiveBlocksPerMultiprocessor(&per_cu, (const void*)fwd_megakernel, NTHREADS, LDS_BYTES);
        if (per_cu < 1) { fprintf(stderr, "kernel_launch: occupancy query says %d blocks/CU\n", per_cu); per_cu = 1; }
        (void)hipGetLastError();
        grid = cus;
    }
    if (grid < 0) return;
    Params p{};
    p.x = (const float*)d_in[0]; p.c = (const float*)d_in[1]; p.ctx = (const float*)d_in[2]; p.c_ctx = (const float*)d_in[3];
    p.w_ada = (const float*)d_in[4]; p.b_ada = (const float*)d_in[5]; p.w_in = (const float*)d_in[6]; p.rpb = (const float*)d_in[7];
    p.lb_fwd = (const float*)d_in[8]; p.lb_bwd = (const float*)d_in[9]; p.hg_nw = (const float*)d_in[10]; p.w_pa = (const float*)d_in[11];
    p.w_pb = (const float*)d_in[12]; p.w_out = (const float*)d_in[13]; p.ln_g = (const float*)d_in[14]; p.ln_b = (const float*)d_in[15];
    p.out = (float*)d_out; p.ws = (unsigned char*)d_ws; p.ph_lo = 0; p.ph_hi = 8;
    void* args[] = {&p};
    if (hipMemsetAsync((char*)d_ws + WS_BAR, 0, ZERO_BYTES, stream) != hipSuccess) { fprintf(stderr, "kernel_launch: memset of barrier words failed\n"); return; }
    hipError_t e = hipLaunchCooperativeKernel((const void*)fwd_megakernel, dim3(grid), dim3(NTHREADS), args, LDS_BYTES, stream);
    if (e != hipSuccess) fprintf(stderr, "cooperative launch failed: %s (grid %d)\n", hipGetErrorString(e), grid);
}
```
